# Optimizing an MI355X kernel written in HIP

```python
import math
import jax, jax.numpy as jnp
from jax import lax
import numpy as np

D_MODEL = 1024
BATCH = 8
SEQ = 4096
DEPTH = 2

HEAD_DIM = 64
A_Q_HEADS = 4
A_KV_HEADS = 2
B_Q_HEADS = 4
B_KV_HEADS = 2
A_WIDTH = A_Q_HEADS * HEAD_DIM
A_KV_WIDTH = A_KV_HEADS * HEAD_DIM
B_WIDTH = B_Q_HEADS * HEAD_DIM
B_KV_WIDTH = B_KV_HEADS * HEAD_DIM
C_WIDTH = D_MODEL // 2
C_GROUP_CH = 16
C_GROUPS = C_WIDTH // C_GROUP_CH
C_STATE = 64
MIX_WIDTH = A_WIDTH + B_WIDTH + C_WIDTH
IN_COLS = A_WIDTH + 2 * A_KV_WIDTH + B_WIDTH + 2 * B_KV_WIDTH + C_WIDTH
SPLIT_IDX = (A_WIDTH,
             A_WIDTH + A_KV_WIDTH,
             A_WIDTH + 2 * A_KV_WIDTH,
             A_WIDTH + 2 * A_KV_WIDTH + B_WIDTH,
             A_WIDTH + 2 * A_KV_WIDTH + B_WIDTH + B_KV_WIDTH,
             A_WIDTH + 2 * A_KV_WIDTH + B_WIDTH + 2 * B_KV_WIDTH)
BLOCK = 128
WINDOW = 128
GRID_W = 64
ROPE_THETA = 10000.0
EPS = 1e-6
NEG_INF = -1e30
DT_MIN = 1e-3
DT_MAX = 1e-1
LAMBDA_RE_MAX = -1e-4
N_EGROUPS = 4
N_EPG = 4
N_EXPERTS = N_EGROUPS * N_EPG
D_EXPERT = D_MODEL // 4
TOP_K_FINE = 2

kernel_name = 'hymba_style_axial_window_s5_hiermoe_encoder'


def _rmsnorm(x, g):
    xf = x.astype(jnp.float32)
    y = xf * lax.rsqrt(jnp.mean(xf * xf, axis=-1, keepdims=True) + EPS)
    return (y * g.astype(jnp.float32)).astype(x.dtype)


def _axial_angles(L):
    rows = L // GRID_W
    t = jnp.arange(rows * GRID_W)
    row = (t // GRID_W).astype(jnp.float32)
    col = (t % GRID_W).astype(jnp.float32)
    n = HEAD_DIM // 4
    inv = ROPE_THETA ** (-jnp.arange(n, dtype=jnp.float32) / n)
    return row[:, None] * inv, col[:, None] * inv


def _rope_half(x, ang):
    n = ang.shape[-1]
    x1, x2 = x[..., :n], x[..., n:]
    c = jnp.cos(ang)[:, None, :]
    s = jnp.sin(ang)[:, None, :]
    return jnp.concatenate([x1 * c - x2 * s, x1 * s + x2 * c], axis=-1)


def _axial_rope(x, ang_row, ang_col):
    half = HEAD_DIM // 2
    xf = x.astype(jnp.float32)
    out = jnp.concatenate([_rope_half(xf[..., :half], ang_row),
                           _rope_half(xf[..., half:], ang_col)], axis=-1)
    return out.astype(x.dtype)


def _alibi_slopes(n):
    return jnp.asarray(2.0 ** (-8.0 * np.arange(1, n + 1) / n), dtype=jnp.float32)


def _global_axial_attention(q, k, v, ang_row, ang_col):
    bn, L = q.shape[:2]
    nblk = L // BLOCK
    grp = A_Q_HEADS // A_KV_HEADS
    q = _axial_rope(q, ang_row, ang_col)
    k = _axial_rope(k, ang_row, ang_col)
    scale = HEAD_DIM ** -0.5
    qb = q.reshape(bn, nblk, BLOCK, A_KV_HEADS, grp, HEAD_DIM).transpose(1, 0, 2, 3, 4, 5)

    def one_block(qblk):
        s = jnp.einsum('bqkgd,bskd->bkgqs', qblk, k, preferred_element_type=jnp.float32) * scale
        p = jax.nn.softmax(s, axis=-1).astype(v.dtype)
        return jnp.einsum('bkgqs,bskd->bqkgd', p, v)

    o = lax.map(one_block, qb)
    return o.transpose(1, 0, 2, 3, 4, 5).reshape(bn, L, A_Q_HEADS * HEAD_DIM)


def _window_alibi_sink_attention(q, k, v, sink):
    bn, L = q.shape[:2]
    nblk = L // BLOCK
    grp = B_Q_HEADS // B_KV_HEADS
    scale = HEAD_DIM ** -0.5
    qb = q.reshape(bn, nblk, BLOCK, B_KV_HEADS, grp, HEAD_DIM)

    def band(t):
        tp = jnp.pad(t, ((0, 0), (BLOCK, BLOCK), (0, 0), (0, 0)))
        tp = tp.reshape(bn, nblk + 2, BLOCK, B_KV_HEADS, HEAD_DIM)
        return jnp.concatenate([tp[:, :-2], tp[:, 1:-1], tp[:, 2:]], axis=2)

    kb, vb = band(k), band(v)
    s = jnp.einsum('bnqkgd,bnskd->bnkgqs', qb, kb, preferred_element_type=jnp.float32) * scale
    rel = jnp.arange(3 * BLOCK)[None, :] - BLOCK - jnp.arange(BLOCK)[:, None]
    dist = jnp.abs(rel).astype(jnp.float32)
    kpos = jnp.arange(nblk)[:, None] * BLOCK - BLOCK + jnp.arange(3 * BLOCK)[None, :]
    valid = (jnp.abs(rel) <= WINDOW)[None] & ((kpos >= 0) & (kpos < L))[:, None, :]
    slopes = _alibi_slopes(B_Q_HEADS).reshape(B_KV_HEADS, grp)
    s = s - slopes[:, :, None, None] * dist
    s = jnp.where(valid[None, :, None, None], s, NEG_INF)
    sink_l = jnp.broadcast_to(sink.astype(jnp.float32).reshape(B_KV_HEADS, grp)[:, :, None, None],
                              s.shape[:-1] + (1,))
    p = jax.nn.softmax(jnp.concatenate([s, sink_l], axis=-1), axis=-1)[..., :-1].astype(v.dtype)
    o = jnp.einsum('bnkgqs,bnskd->bnqkgd', p, vb)
    return o.reshape(bn, L, B_Q_HEADS * HEAD_DIM)


def _complex_linear_combine(e1, e2):
    a1r, a1i, b1r, b1i = e1
    a2r, a2i, b2r, b2i = e2
    return (a2r * a1r - a2i * a1i,
            a2r * a1i + a2i * a1r,
            a2r * b1r - a2i * b1i + b2r,
            a2r * b1i + a2i * b1r + b2i)


def _s5_direction(u, lam_re, lam_im, log_dt, b_re, b_im, c_re, c_im, reverse):
    dt = jnp.exp(log_dt.astype(jnp.float32))[:, None]
    lr = jnp.minimum(lam_re.astype(jnp.float32), LAMBDA_RE_MAX)
    li = lam_im.astype(jnp.float32)
    mag = jnp.exp(lr * dt)
    ph = li * dt
    abar_re = mag * jnp.cos(ph)
    abar_im = mag * jnp.sin(ph)
    den = lr * lr + li * li
    nr = abar_re - 1.0
    ni = abar_im
    coef_re = ((nr * lr + ni * li) / den)[..., None]
    coef_im = ((ni * lr - nr * li) / den)[..., None]
    br = b_re.astype(jnp.float32)
    bi = b_im.astype(jnp.float32)
    bbar_re = coef_re * br - coef_im * bi
    bbar_im = coef_re * bi + coef_im * br
    bu_re = jnp.einsum('blgh,gph->blgp', u, bbar_re)
    bu_im = jnp.einsum('blgh,gph->blgp', u, bbar_im)
    L = u.shape[1]
    a_re = jnp.broadcast_to(abar_re, (1, L) + abar_re.shape)
    a_im = jnp.broadcast_to(abar_im, (1, L) + abar_im.shape)
    _, _, x_re, x_im = lax.associative_scan(_complex_linear_combine, (a_re, a_im, bu_re, bu_im),
                                            reverse=reverse, axis=1)
    return (jnp.einsum('blgp,ghp->blgh', x_re, c_re.astype(jnp.float32))
            - jnp.einsum('blgp,ghp->blgh', x_im, c_im.astype(jnp.float32)))


def _s5_mixer(u, lam_re, lam_im, log_dt, b_re, b_im, c_re, c_im, d_skip, glu_w, glu_b):
    bn, L, _ = u.shape
    uf = u.astype(jnp.float32).reshape(bn, L, C_GROUPS, C_GROUP_CH)
    y = (d_skip.astype(jnp.float32) * uf
         + _s5_direction(uf, lam_re[0], lam_im[0], log_dt[0], b_re[0], b_im[0], c_re[0], c_im[0], False)
         + _s5_direction(uf, lam_re[1], lam_im[1], log_dt[1], b_re[1], b_im[1], c_re[1], c_im[1], True))
    y = jax.nn.gelu(y.reshape(bn, L, C_WIDTH))
    gate = jax.nn.sigmoid(y @ glu_w.astype(jnp.float32) + glu_b.astype(jnp.float32))
    return (y * gate).astype(u.dtype)


def _hier_moe(h, wc, bc, wf, bf, wg, wu, wd):
    bn, L, _ = h.shape
    hf = h.astype(jnp.float32)
    coarse = hf @ wc.astype(jnp.float32) + bc.astype(jnp.float32)
    p_coarse = jax.nn.softmax(coarse, axis=-1)
    top_p, top_g = lax.top_k(p_coarse, 1)
    fine_all = jnp.einsum('bld,dge->blge', hf, wf.astype(jnp.float32)) + bf.astype(jnp.float32)
    fine = jnp.take_along_axis(fine_all, top_g[..., None], axis=2)[:, :, 0]
    f_val, f_idx = lax.top_k(fine, TOP_K_FINE)
    f_w = jax.nn.softmax(f_val, axis=-1)
    fine_w = jnp.sum(jax.nn.one_hot(f_idx, N_EPG, dtype=jnp.float32) * f_w[..., None], axis=-2)
    combine = (jax.nn.one_hot(top_g[..., 0], N_EGROUPS, dtype=jnp.float32)[..., None]
               * (top_p[..., None] * fine_w[:, :, None, :])).reshape(bn, L, N_EXPERTS)
    gate = jnp.einsum('bld,edf->blef', h, wg)
    up = jnp.einsum('bld,edf->blef', h, wu)
    act = jax.nn.silu(gate) * up * combine[..., None].astype(h.dtype)
    return jnp.einsum('blef,efd->bld', act, wd)


def setup_inputs(seed: int = 0) -> dict:
    key = jax.random.key(seed)
    ks = jax.random.split(key, 28)

    def nrm(i, shape, scale):
        return scale * jax.random.normal(ks[i], shape, jnp.float32)

    G, P, H = C_GROUPS, C_STATE, C_GROUP_CH
    n_idx = jnp.arange(P, dtype=jnp.float32)
    return {
        'x': nrm(0, (BATCH, SEQ, D_MODEL), 1.0),
        'ln1_g': 1.0 + nrm(1, (DEPTH, D_MODEL), 0.02),
        'w_in': nrm(2, (DEPTH, D_MODEL, IN_COLS), D_MODEL ** -0.5),
        'q_norm_a': 1.0 + nrm(3, (DEPTH, HEAD_DIM), 0.02),
        'k_norm_a': 1.0 + nrm(4, (DEPTH, HEAD_DIM), 0.02),
        'q_norm_b': 1.0 + nrm(5, (DEPTH, HEAD_DIM), 0.02),
        'k_norm_b': 1.0 + nrm(6, (DEPTH, HEAD_DIM), 0.02),
        'sink_b': nrm(7, (DEPTH, B_Q_HEADS), 0.5),
        's5_lam_re': -0.5 + nrm(8, (DEPTH, 2, G, P), 0.01),
        's5_lam_im': math.pi * n_idx + nrm(9, (DEPTH, 2, G, P), 0.01),
        's5_log_dt': jax.random.uniform(ks[10], (DEPTH, 2, G), dtype=jnp.float32,
                                        minval=math.log(DT_MIN), maxval=math.log(DT_MAX)),
        's5_b_re': nrm(11, (DEPTH, 2, G, P, H), (2 * H) ** -0.5),
        's5_b_im': nrm(12, (DEPTH, 2, G, P, H), (2 * H) ** -0.5),
        's5_c_re': nrm(13, (DEPTH, 2, G, H, P), P ** -0.5),
        's5_c_im': nrm(14, (DEPTH, 2, G, H, P), P ** -0.5),
        's5_d': nrm(15, (DEPTH, G, H), 0.5),
        'glu_w': nrm(16, (DEPTH, C_WIDTH, C_WIDTH), C_WIDTH ** -0.5),
        'glu_b': nrm(17, (DEPTH, C_WIDTH), 0.01),
        'out_norm_g': 1.0 + nrm(18, (DEPTH, MIX_WIDTH), 0.02),
        'w_out': nrm(19, (DEPTH, MIX_WIDTH, D_MODEL), MIX_WIDTH ** -0.5),
        'ln2_g': 1.0 + nrm(20, (DEPTH, D_MODEL), 0.02),
        'router_c_w': nrm(21, (DEPTH, D_MODEL, N_EGROUPS), D_MODEL ** -0.5),
        'router_c_b': nrm(22, (DEPTH, N_EGROUPS), 0.01),
        'router_f_w': nrm(23, (DEPTH, D_MODEL, N_EGROUPS, N_EPG), D_MODEL ** -0.5),
        'router_f_b': nrm(24, (DEPTH, N_EGROUPS, N_EPG), 0.01),
        'exp_w_gate': nrm(25, (DEPTH, N_EXPERTS, D_MODEL, D_EXPERT), D_MODEL ** -0.5),
        'exp_w_up': nrm(26, (DEPTH, N_EXPERTS, D_MODEL, D_EXPERT), D_MODEL ** -0.5),
        'exp_w_down': nrm(27, (DEPTH, N_EXPERTS, D_EXPERT, D_MODEL), D_EXPERT ** -0.5),
    }


def reference(x, ln1_g, w_in, q_norm_a, k_norm_a, q_norm_b, k_norm_b, sink_b,
              s5_lam_re, s5_lam_im, s5_log_dt, s5_b_re, s5_b_im, s5_c_re, s5_c_im, s5_d,
              glu_w, glu_b, out_norm_g, w_out, ln2_g,
              router_c_w, router_c_b, router_f_w, router_f_b,
              exp_w_gate, exp_w_up, exp_w_down):
    bn, L, _ = x.shape
    ang_row, ang_col = _axial_angles(L)
    for l in range(DEPTH):
        h = _rmsnorm(x, ln1_g[l])
        proj = h @ w_in[l]
        qa, ka, va, qb, kb, vb, uc = jnp.split(proj, SPLIT_IDX, axis=-1)
        qa = _rmsnorm(qa.reshape(bn, L, A_Q_HEADS, HEAD_DIM), q_norm_a[l])
        ka = _rmsnorm(ka.reshape(bn, L, A_KV_HEADS, HEAD_DIM), k_norm_a[l])
        va = va.reshape(bn, L, A_KV_HEADS, HEAD_DIM)
        ya = _global_axial_attention(qa, ka, va, ang_row, ang_col)
        qb = _rmsnorm(qb.reshape(bn, L, B_Q_HEADS, HEAD_DIM), q_norm_b[l])
        kb = _rmsnorm(kb.reshape(bn, L, B_KV_HEADS, HEAD_DIM), k_norm_b[l])
        vb = vb.reshape(bn, L, B_KV_HEADS, HEAD_DIM)
        yb = _window_alibi_sink_attention(qb, kb, vb, sink_b[l])
        yc = _s5_mixer(uc, s5_lam_re[l], s5_lam_im[l], s5_log_dt[l], s5_b_re[l], s5_b_im[l],
                       s5_c_re[l], s5_c_im[l], s5_d[l], glu_w[l], glu_b[l])
        g_a, g_b, g_c = jnp.split(out_norm_g[l], (A_WIDTH, A_WIDTH + B_WIDTH))
        mixed = jnp.concatenate([_rmsnorm(ya, g_a), _rmsnorm(yb, g_b), _rmsnorm(yc, g_c)], axis=-1)
        x = x + mixed @ w_out[l]
        h = _rmsnorm(x, ln2_g[l])
        x = x + _hier_moe(h, router_c_w[l], router_c_b[l], router_f_w[l], router_f_b[l],
                          exp_w_gate[l], exp_w_up[l], exp_w_down[l])
    return x
```

```cpp
#include <hip/hip_runtime.h>
#include <cstdio>
#include <cstdint>

constexpr int DM = 1024, NB = 8, SEQ = 4096, DEPTH = 2, T = NB * SEQ;
constexpr int HD = 64, INC = 1536, CW = 512, NG = 32, GC = 16, NS = 64;
constexpr int NEXP = 16, DEXP = 256;
constexpr float EPS = 1e-6f;
constexpr float LOG2E = 1.4426950408889634f;
constexpr float QSCALE = 0.125f * LOG2E;
constexpr int CH = 32, NCH = SEQ / CH;
constexpr int UXP = 768;

typedef unsigned short bf16;
typedef float f32x2_cv __attribute__((ext_vector_type(2))); typedef __bf16 bf16x2_cv __attribute__((ext_vector_type(2)));
__device__ __forceinline__ unsigned pk2(float lo, float hi) { const f32x2_cv v = {lo, hi}; return __builtin_bit_cast(unsigned, __builtin_convertvector(v, bf16x2_cv)); }
__device__ __forceinline__ unsigned f2bf(float f) { return pk2(f, 0.f) & 0xffffu; }
__device__ __forceinline__ float bf2f(unsigned h) { return __builtin_bit_cast(float, h << 16); }
__device__ __forceinline__ float bfr(float f) { return bf2f(f2bf(f)); }

constexpr size_t MiB = 1u << 20;
constexpr size_t WS_CTL = 0;
constexpr size_t WS_SSQX = 1 * MiB;
constexpr size_t WS_SSQA = 3 * MiB;
constexpr size_t WS_SSQB = 4 * MiB;
constexpr size_t WS_SSQC = 5 * MiB;
constexpr size_t WS_XB = 8 * MiB;
constexpr size_t WS_QA = 72 * MiB;
constexpr size_t WS_KA = 88 * MiB;
constexpr size_t WS_VA = 96 * MiB;
constexpr size_t WS_QB = 104 * MiB;
constexpr size_t WS_KB = 120 * MiB;
constexpr size_t WS_VB = 128 * MiB;
constexpr size_t WS_UX = 136 * MiB;
constexpr size_t WS_XEND = 184 * MiB;
constexpr size_t WS_YC = 216 * MiB;
constexpr size_t WS_MIX = 248 * MiB;
constexpr size_t WS_YTMP = 312 * MiB;
constexpr size_t WS_END = 376 * MiB;

struct P {
    const float* in[28];
    float* out;
    unsigned char* ws;
};

template <int CTRL> __device__ __forceinline__ float dpp_add(float v) { return v + __builtin_bit_cast(float, __builtin_amdgcn_update_dpp(0, __builtin_bit_cast(int, v), CTRL, 0xf, 0xf, true)); }
__device__ __forceinline__ float sum8(float v) { v = dpp_add<0xB1>(v); v = dpp_add<0x4E>(v); return dpp_add<0x141>(v); }
__device__ __forceinline__ float wave_sum(float v) {
    v = dpp_add<0x140>(sum8(v));
    const int b = __builtin_bit_cast(int, v);
    return (__builtin_bit_cast(float, __builtin_amdgcn_readlane(b, 0)) + __builtin_bit_cast(float, __builtin_amdgcn_readlane(b, 16))) + (__builtin_bit_cast(float, __builtin_amdgcn_readlane(b, 32)) + __builtin_bit_cast(float, __builtin_amdgcn_readlane(b, 48)));
}
__device__ __forceinline__ float sum_xor16(float v) { auto r = __builtin_amdgcn_permlane16_swap(__float_as_uint(v), __float_as_uint(v), false, false); return __uint_as_float(r[0]) + __uint_as_float(r[1]); }
__device__ __forceinline__ float sum_xor32(float v) { auto r = __builtin_amdgcn_permlane32_swap(__float_as_uint(v), __float_as_uint(v), false, false); return __uint_as_float(r[0]) + __uint_as_float(r[1]); }
__device__ __forceinline__ float other_xor32(float v, bool upper) { auto r = __builtin_amdgcn_permlane32_swap(__float_as_uint(v), __float_as_uint(v), false, false); return __uint_as_float(upper ? r[0] : r[1]); }
__device__ __forceinline__ float block_sum256(float v, float* red) {
    v = wave_sum(v);
    __syncthreads();
    if ((threadIdx.x & 63) == 0) red[threadIdx.x >> 6] = v;
    __syncthreads();
    return red[0] + red[1] + red[2] + red[3];
}


typedef unsigned u32x4_wt __attribute__((ext_vector_type(4)));
__device__ __forceinline__ void st16_wt(void* p, u32x4_wt v) { asm volatile("global_store_dwordx4 %0, %1, off sc1\n\ts_nop 1" :: "v"(p), "v"(v) : "memory"); }

#define LAS __attribute__((address_space(3)))
#define GAS __attribute__((address_space(1)))
typedef short bf16x8 __attribute__((ext_vector_type(8)));
typedef float f32x4 __attribute__((ext_vector_type(4)));
typedef float f32x2 __attribute__((ext_vector_type(2)));
typedef unsigned u32x4 __attribute__((ext_vector_type(4)));
typedef unsigned u32x2 __attribute__((ext_vector_type(2)));
constexpr int NWAVES = 8, NTHR = 512;
constexpr int RING_BYTES = 131072, LDS_BYTES = 160 * 1024, LDS_MISC = LDS_BYTES - 256;
constexpr int LDS_EPI = RING_BYTES, LDS_EPI_WAVE = 1536;
constexpr int LDS_ROPE = LDS_EPI + 8 * LDS_EPI_WAVE;

constexpr size_t WS_W = 376 * MiB;
constexpr size_t WL_WIN = 0;
constexpr size_t WL_WOUT = 3 * MiB;
constexpr size_t WL_WGLU = 5 * MiB;
constexpr size_t WL_WR = 5 * MiB + 512 * 1024;
constexpr size_t WL_A32 = 5 * MiB + 768 * 1024;
constexpr size_t WL_WGU = 6 * MiB;
constexpr size_t WL_WDN = 22 * MiB;
constexpr size_t WL_S5B2 = 30 * MiB;
constexpr size_t WL_S5B1 = 54 * MiB;
constexpr size_t WL_SIZE = 62 * MiB;
constexpr size_t WS_ROPE = WS_W + 2 * WL_SIZE;
constexpr size_t WS_END2 = WS_ROPE + 1 * MiB;


namespace g8 {
constexpr int BM = 256, BK = 64, HALF = 128, HTB = HALF * BK * 2, STAGE_BYTES = 8 * HTB, NXCD = 8, WGM = 8;
__device__ __forceinline__ int lds_byte(int r, int c) { const int st = (r >> 4) * 2 + (c >> 5), rr = r & 15, cc = c & 31, ob = rr * 64 + cc * 2; return st * 1024 + (ob ^ (((ob >> 9) & 1) << 5)); }
__device__ __forceinline__ void stage_rc(int b, int& R, int& C) { const int st = b / 1024, sb = b % 1024, swz = sb ^ (((sb >> 9) & 1) << 5); R = (st >> 1) * 16 + swz / 64; C = (st & 1) * 32 + (swz % 64) / 2; }
__device__ __forceinline__ int perm32(int rho) { const int n = rho >> 4, i = rho & 15; return 8 * (i >> 2) + 4 * n + (i & 3); }

struct Unit {
    unsigned A, B;
    unsigned lda, ldb;
    int nt;
    int fin;
    const int* rows;
    int nv;
    int pm, pn, a0, r0;
    int kind, dep;
    unsigned B2;
};
__device__ __forceinline__ bool tile_order(int L, int nM, int nN, int& pm, int& pn) {
    const int nwg = nM * nN; if (L >= nwg) return false;
    int wgid = L; { const int q = nwg / NXCD, r = nwg % NXCD, xcd = wgid % NXCD, off = wgid / NXCD; wgid = (xcd < r ? xcd * (q + 1) : r * (q + 1) + (xcd - r) * q) + off; }
    const int nig = WGM * nN, gid = wgid / nig, fm = gid * WGM, gsz = (nM - fm) < WGM ? (nM - fm) : WGM;
    pm = fm + ((wgid % nig) % gsz); pn = (wgid % nig) / gsz; return true;
}


__device__ __forceinline__ void unit_ready(const Unit& u, unsigned char* wsbase, int wid) {
    if (u.dep < 0) return;
    if (wid == 0) {
        unsigned* w = (unsigned*)wsbase + u.dep; unsigned spins = 0;
        while ((unsigned)__builtin_amdgcn_readfirstlane(__hip_atomic_load(w, __ATOMIC_RELAXED, __HIP_MEMORY_SCOPE_AGENT)) < 32u) { __builtin_amdgcn_s_sleep(2); if (++spins > (1u << 17)) break; }
        __builtin_amdgcn_fence(__ATOMIC_ACQUIRE, "agent");
        asm volatile("s_waitcnt vmcnt(0)" ::: "memory");
    }
    asm volatile("" ::: "memory"); __builtin_amdgcn_s_barrier(); asm volatile("" ::: "memory");
}

template <class Epi, class Sched>
__device__ __forceinline__ void gemm_phase(LAS unsigned char* lds, const int tid, unsigned char* wsbase, const Sched& S, const Epi& E) {
    const __amdgpu_buffer_rsrc_t rsrc = __builtin_amdgcn_make_buffer_rsrc((void*)wsbase, 0, 0x7fffffff, 0x00020000);
    const int wid = __builtin_amdgcn_readfirstlane(tid >> 6), lane = tid & 63, wr = wid >> 2, wc = wid & 3, fr = lane & 15, fq = lane >> 4;
    int R0, C0, R1, C1; stage_rc(tid * 16, R0, C0); stage_rc(tid * 16 + 8192, R1, C1);
    const int Rb0 = (R0 & ~31) + perm32(R0 & 31), Rb1 = (R1 & ~31) + perm32(R1 & 31);
    const unsigned ldsw = (unsigned)wid * 1024u;
    const int aoff = lds_byte(wr * 64 + fr, fq * 8), boff = lds_byte(wc * 32 + fr, fq * 8);
#define G8_SA(b, h) (((b) * 2 + (h)) * HTB)
#define G8_SB(b, h) ((4 + (b) * 2 + (h)) * HTB)
#define G8_STG(bufoff, gbase, o0, o1) do { \
        __builtin_amdgcn_raw_ptr_buffer_load_lds(rsrc, (LAS unsigned*)(lds + (bufoff) + ldsw), 16, (o0), (gbase), 0, 0); \
        __builtin_amdgcn_raw_ptr_buffer_load_lds(rsrc, (LAS unsigned*)(lds + (bufoff) + ldsw + 8192), 16, (o1), (gbase), 0, 0); } while (0)
#define G8_LDA(dst, b, h) do { _Pragma("unroll") for (int m = 0; m < 4; ++m) _Pragma("unroll") for (int k = 0; k < 2; ++k) dst[m][k] = *(const LAS bf16x8*)(lds + G8_SA(b, h) + aoff + m * 2048 + k * 1024); } while (0)
#define G8_LDB(dst, b, h) do { _Pragma("unroll") for (int n = 0; n < 2; ++n) _Pragma("unroll") for (int k = 0; k < 2; ++k) dst[n][k] = *(const LAS bf16x8*)(lds + G8_SB(b, h) + boff + n * 2048 + k * 1024); } while (0)
#define G8_MMA(ai, bj, At, Bt) do { __builtin_amdgcn_s_setprio(1); _Pragma("unroll") for (int m = 0; m < 4; ++m) _Pragma("unroll") for (int n = 0; n < 2; ++n) _Pragma("unroll") for (int k = 0; k < 2; ++k) \
        acc[ai][bj][m][n] = __builtin_amdgcn_mfma_f32_16x16x32_bf16(Bt[n][k], At[m][k], acc[ai][bj][m][n], 0, 0, 0); __builtin_amdgcn_s_setprio(0); } while (0)
#define G8_WAIT_V(n) asm volatile("s_waitcnt vmcnt(" #n ")" ::: "memory")
#define G8_WAIT_L(n) asm volatile("s_waitcnt lgkmcnt(" #n ")" ::: "memory")
#define G8_BAR __builtin_amdgcn_s_barrier()
#define G8_SCHED __builtin_amdgcn_sched_barrier(0)
#define G8_OFFS(u, a00, a01, a10, a11, b0, b1) do { \
        int i00 = R0, i01 = R1, i10 = 128 + R0, i11 = 128 + R1; \
        if ((u).rows) { i00 = R0 < (u).nv ? (u).rows[R0] : 0; i01 = R1 < (u).nv ? (u).rows[R1] : 0; i10 = 128 + R0 < (u).nv ? (u).rows[128 + R0] : 0; i11 = 128 + R1 < (u).nv ? (u).rows[128 + R1] : 0; } \
        a00 = (unsigned)i00 * (u).lda + (unsigned)C0 * 2u; a01 = (unsigned)i01 * (u).lda + (unsigned)C1 * 2u; \
        a10 = (unsigned)i10 * (u).lda + (unsigned)C0 * 2u; a11 = (unsigned)i11 * (u).lda + (unsigned)C1 * 2u; \
        b0 = (unsigned)Rb0 * (u).ldb + (unsigned)C0 * 2u; b1 = (unsigned)Rb1 * (u).ldb + (unsigned)C1 * 2u; } while (0)
    Unit cur, nxt; int ui = 0;
    if (!S.next(0, cur)) return;
    unit_ready(cur, wsbase, wid);
    unsigned vA00, vA01, vA10, vA11, vB0, vB1, nA00, nA01, nA10, nA11, nB0, nB1;
    G8_OFFS(cur, vA00, vA01, vA10, vA11, vB0, vB1);
    f32x4 acc[2][2][4][2];
#pragma unroll
    for (int a = 0; a < 2; ++a)
#pragma unroll
        for (int b = 0; b < 2; ++b)
#pragma unroll
            for (int m = 0; m < 4; ++m)
#pragma unroll
                for (int n = 0; n < 2; ++n) acc[a][b][m][n] = (f32x4){0.f, 0.f, 0.f, 0.f};
    bf16x8 At[4][2], B0[2][2], B1[2][2];
    unsigned cA = cur.A, cB = cur.B, hsB = (unsigned)HALF * cur.ldb;
    G8_STG(G8_SB(0, 0), cB, vB0, vB1); G8_STG(G8_SB(0, 1), cB + hsB, vB0, vB1); G8_STG(G8_SA(0, 0), cA, vA00, vA01); G8_STG(G8_SA(0, 1), cA, vA10, vA11);
    if (wr == 1) G8_BAR;
    G8_WAIT_V(2); G8_BAR;
    G8_STG(G8_SB(1, 0), cB + 128, vB0, vB1); G8_STG(G8_SA(1, 0), cA + 128, vA00, vA01); G8_STG(G8_SB(1, 1), cB + hsB + 128, vB0, vB1);
    G8_WAIT_V(6); G8_BAR;
    for (;;) {
        const bool has_next = S.next(ui + 1, nxt);
        unsigned nA = cA, nB = cB, nhsB = hsB;
        nA00 = vA00; nA01 = vA01; nA10 = vA10; nA11 = vA11; nB0 = vB0; nB1 = vB1;
        if (has_next) { G8_OFFS(nxt, nA00, nA01, nA10, nA11, nB0, nB1); nA = nxt.A; nB = nxt.B; nhsB = (unsigned)HALF * nxt.ldb; }
        const int nt = cur.nt;
        for (int t = 0; t < nt; t += 2) {
            const bool last = (t == nt - 2);
            if (last && has_next) unit_ready(nxt, wsbase, wid);
            const unsigned a1 = cA + (unsigned)(t + 1) * 128u;
            const unsigned a2 = last ? nA : cA + (unsigned)(t + 2) * 128u, b2 = last ? nB : ((cur.B2 == 0u || t + 2 < (nt >> 1)) ? cB + (unsigned)(t + 2) * 128u : cur.B2 + (unsigned)(t + 2 - (nt >> 1)) * 128u);
            const unsigned hs2 = last ? nhsB : hsB;
            const unsigned oA00 = last ? nA00 : vA00, oA01 = last ? nA01 : vA01, oA10 = last ? nA10 : vA10, oA11 = last ? nA11 : vA11, oB0 = last ? nB0 : vB0, oB1 = last ? nB1 : vB1;
            const unsigned a3 = a2 + 128u, b3 = b2 + 128u;
            G8_LDB(B0, 0, 0); G8_LDB(B1, 0, 1); G8_SCHED; G8_LDA(At, 0, 0); G8_STG(G8_SA(1, 1), a1, vA10, vA11);
            G8_WAIT_V(8); G8_WAIT_L(0); G8_BAR; G8_MMA(0, 0, At, B0); G8_MMA(0, 1, At, B1); G8_BAR; G8_SCHED;
            G8_LDA(At, 0, 1); G8_STG(G8_SB(0, 0), b2, oB0, oB1); G8_STG(G8_SB(0, 1), b2 + hs2, oB0, oB1); G8_STG(G8_SA(0, 0), a2, oA00, oA01);
            G8_WAIT_V(8); G8_WAIT_L(0); G8_BAR; G8_MMA(1, 0, At, B0); G8_MMA(1, 1, At, B1); G8_BAR; G8_SCHED;
            G8_LDB(B0, 1, 0); G8_LDB(B1, 1, 1); G8_SCHED; G8_LDA(At, 1, 0); G8_STG(G8_SA(0, 1), a2, oA10, oA11);
            G8_WAIT_V(8); G8_WAIT_L(0); G8_BAR; G8_MMA(0, 0, At, B0); G8_MMA(0, 1, At, B1); G8_BAR; G8_SCHED;
            G8_LDA(At, 1, 1); G8_STG(G8_SB(1, 0), b3, oB0, oB1); G8_STG(G8_SB(1, 1), b3 + hs2, oB0, oB1); G8_STG(G8_SA(1, 0), a3, oA00, oA01);
            G8_WAIT_V(8); G8_WAIT_L(0); G8_BAR; G8_MMA(1, 0, At, B0); G8_MMA(1, 1, At, B1); G8_BAR; G8_SCHED;
        }
        if (wr == 0) G8_BAR;
        { int fr_ = fr, fq_ = fq; asm volatile("" : "+v"(fr_), "+v"(fq_));
          E(acc, cur, wr, wc, fr_, fq_, lds + LDS_EPI + wid * LDS_EPI_WAVE); }
        if (!has_next) break;
        if (cur.fin) {
#pragma unroll
            for (int a = 0; a < 2; ++a)
#pragma unroll
                for (int b = 0; b < 2; ++b)
#pragma unroll
                    for (int m = 0; m < 4; ++m)
#pragma unroll
                        for (int n = 0; n < 2; ++n) acc[a][b][m][n] = (f32x4){0.f, 0.f, 0.f, 0.f};
        }
        cur = nxt; cA = nA; cB = nB; hsB = nhsB; vA00 = nA00; vA01 = nA01; vA10 = nA10; vA11 = nA11; vB0 = nB0; vB1 = nB1; ++ui;
        if (wr == 1) G8_BAR;
    }
    G8_WAIT_V(0);
    G8_BAR;
#undef G8_SA
#undef G8_SB
#undef G8_STG
#undef G8_LDA
#undef G8_LDB
#undef G8_MMA
#undef G8_WAIT_V
#undef G8_WAIT_L
#undef G8_BAR
#undef G8_SCHED
#undef G8_OFFS
}
}

struct Frame {
    LAS unsigned char* lds; char* ldsg;
    const LAS P* pl;
    unsigned char* ws; float* out;
    int tid, lane, wave, vcu, G;
};
__device__ __forceinline__ const void* uniptr(const void* q) { const unsigned long long v = (unsigned long long)q; const unsigned lo = __builtin_amdgcn_readfirstlane((unsigned)v), hi = __builtin_amdgcn_readfirstlane((unsigned)(v >> 32)); return (const void*)(((unsigned long long)hi << 32) | lo); }
#define PINP(i) ((const float*)uniptr(F.pl->in[i]))
constexpr size_t WL_QKG = 5 * MiB + 800 * 1024;
constexpr size_t WL_SINK = WL_QKG + 1024;
constexpr size_t WL_GLUB = WL_QKG + 2048;
constexpr size_t WL_RB = WL_QKG + 4096 + 2048;

__device__ __forceinline__ void s5_prep(Frame& F, int l, int g, int qtr) {
    LAS f32x2* apw = (LAS f32x2*)(F.lds);
    LAS f32x2* bb = (LAS f32x2*)(F.lds + 33792);
    LAS f32x2* cc = (LAS f32x2*)(F.lds + 33792 + 16384);
    LAS float* kt = (LAS float*)(F.lds + 33792 + 32768);
    const int tid = F.tid, lane = F.lane;
    unsigned char* wl = F.ws + WS_W + (size_t)l * WL_SIZE;
    __syncthreads();
    f32x2 cv[4];
#pragma unroll
    for (int k = 0; k < 4; ++k) { const int i = tid + k * NTHR, dir = i >> 10, ho = (i >> 6) & 15, s = i & 63; const size_t pb = (((size_t)l * 2 + dir) * NG + g);
        cv[k] = (f32x2){PINP(13)[(pb * GC + ho) * NS + s], PINP(14)[(pb * GC + ho) * NS + s]}; }
    const float* dsk = PINP(15) + ((size_t)l * NG + g) * GC;
    const float dsk0 = dsk[(tid >> 6) & 15], dsk1 = dsk[((tid >> 6) & 15) + 8];
    if (tid < 128) {
        const int dir = tid >> 6, s = tid & 63;
        const size_t pb = (((size_t)l * 2 + dir) * NG + g);
        const f32x4* brp = (const f32x4*)(PINP(11) + (pb * NS + s) * GC); const f32x4* bip = (const f32x4*)(PINP(12) + (pb * NS + s) * GC);
        f32x4 brv[4], biv[4];
#pragma unroll
        for (int q = 0; q < 4; ++q) { brv[q] = brp[q]; biv[q] = bip[q]; }
        const float ldt = PINP(10)[pb], lr0 = PINP(8)[pb * NS + s], li = PINP(9)[pb * NS + s];
        const float dt = expf(ldt);
        const float lr = fminf(lr0, -1e-4f);
        const float mag = expf(lr * dt), ph = li * dt;
        const float ar = mag * cosf(ph), ai = mag * sinf(ph);
        const float den = lr * lr + li * li, nr = ar - 1.f, ni = ai;
        const float cr = (nr * lr + ni * li) / den, ci = (ni * lr - nr * li) / den;
        double xr = 1.0, xi = 0.0;
        for (int t = 0; t <= 32; ++t) { apw[(dir * 64 + s) * 33 + t] = (f32x2){(float)xr, (float)xi}; const double nxr = xr * ar - xi * ai, nxi = xr * ai + xi * ar; xr = nxr; xi = nxi; }
#pragma unroll
        for (int hi = 0; hi < GC; ++hi) { const float br = brv[hi >> 2][hi & 3], bi = biv[hi >> 2][hi & 3]; bb[(dir * 64 + s) * 16 + hi] = (f32x2){cr * br - ci * bi, cr * bi + ci * br}; }
    }
#pragma unroll
    for (int k = 0; k < 4; ++k) cc[tid + k * NTHR] = cv[k];
    __syncthreads();
    if (qtr == 0 && tid < 128) { const int dir = tid >> 6, s = tid & 63; ((f32x2*)(wl + WL_A32))[(dir * NG + g) * 64 + s] = apw[(dir * 64 + s) * 33 + 32]; }
    {   const int dir = F.wave >> 2, ho = lane & 15, kq = lane >> 4, hi = lane & 15;
        float ar_[32]; f32x2 bq[16];
#pragma unroll
        for (int j = 0; j < 16; ++j) { const f32x2 c = cc[(dir * 16 + ho) * 64 + 4 * j + kq]; ar_[j] = c.x; ar_[16 + j] = -c.y; bq[j] = bb[(dir * 64 + 4 * j + kq) * 16 + hi]; }
        for (int tt = 0; tt < 8; ++tt) { const int tau = (F.wave & 3) * 8 + tt; f32x4 acc = (f32x4){0.f, 0.f, 0.f, 0.f}, acc2 = acc;
#pragma unroll
            for (int j = 0; j < 16; ++j) { const f32x2 w = apw[(dir * 64 + 4 * j + kq) * 33 + tau];
                const float zr = w.x * bq[j].x - w.y * bq[j].y, zi = w.x * bq[j].y + w.y * bq[j].x;
                acc = __builtin_amdgcn_mfma_f32_16x16x4f32(ar_[j], zr, acc, 0, 0, 0); acc2 = __builtin_amdgcn_mfma_f32_16x16x4f32(ar_[16 + j], zi, acc2, 0, 0, 0); }
#pragma unroll
            for (int r = 0; r < 4; ++r) kt[((dir * 32 + tau) * 16 + 4 * kq + r) * 16 + hi] = acc[r] + acc2[r]; }
    }
    __syncthreads();
    bf16* B2 = (bf16*)(wl + WL_S5B2) + (size_t)g * 512 * 768;
    for (int v = tid; v < 128 * 64; v += NTHR) {
        const int n = qtr * 128 + (v >> 6), kv = v & 63, t = n >> 4, ho = n & 15; float o[8];
        {   const int s = kv >> 1, h0 = (kv & 1) * 8;
            f32x4 a0 = (f32x4){0.f, 0.f, 0.f, 0.f}, a1 = a0;
            if (s <= t) { const LAS f32x4* q = (const LAS f32x4*)(kt + ((0 * 32 + (t - s)) * 16 + ho) * 16 + h0); a0 = q[0]; a1 = q[1]; }
            if (s >= t) { const LAS f32x4* q = (const LAS f32x4*)(kt + ((1 * 32 + (s - t)) * 16 + ho) * 16 + h0); a0 = a0 + q[0]; a1 = a1 + q[1]; }
            o[0] = a0.x; o[1] = a0.y; o[2] = a0.z; o[3] = a0.w; o[4] = a1.x; o[5] = a1.y; o[6] = a1.z; o[7] = a1.w;
            if (s == t && (ho >> 3) == (h0 >> 3)) { const float d = (ho & 8) ? dsk1 : dsk0;
#pragma unroll
                for (int e = 0; e < 8; ++e) o[e] += (e == (ho & 7)) ? d : 0.f; }
        }
        u32x4 w4; w4.x = pk2(o[0], o[1]); w4.y = pk2(o[2], o[3]); w4.z = pk2(o[4], o[5]); w4.w = pk2(o[6], o[7]);
        *(u32x4*)(B2 + (size_t)n * 768 + kv * 8) = w4;
    }
    for (int v = tid; v < 128 * 32; v += NTHR) {
        const int n = qtr * 128 + (v >> 5), kv = 64 + (v & 31), t = n >> 4, ho = n & 15; float o[8];
        {   const int j0 = (kv - 64) * 8, q = j0 >> 6, dir = q >> 1, im = q & 1, pw = dir == 0 ? (t + 1) : (32 - t);
#pragma unroll
            for (int e = 0; e < 8; ++e) { const int s = (j0 & 63) + e; const f32x2 c = cc[(dir * 16 + ho) * 64 + s], w = apw[(dir * 64 + s) * 33 + pw];
                o[e] = im ? -(c.x * w.y + c.y * w.x) : (c.x * w.x - c.y * w.y); }
        }
        u32x4 w4; w4.x = pk2(o[0], o[1]); w4.y = pk2(o[2], o[3]); w4.z = pk2(o[4], o[5]); w4.w = pk2(o[6], o[7]);
        *(u32x4*)(B2 + (size_t)n * 768 + kv * 8) = w4;
    }
    bf16* B1 = (bf16*)(wl + WL_S5B1) + (size_t)g * 256 * 512;
    for (int v = tid; v < 64 * 64; v += NTHR) {
        const int j = qtr * 64 + (v >> 6), kv = v & 63, s = kv >> 1, h0 = (kv & 1) * 8, q = j >> 6, dir = q >> 1, im = q & 1, st = j & 63, pw = dir == 0 ? (31 - s) : s;
        const f32x2 w = apw[(dir * 64 + st) * 33 + pw]; float o[8];
#pragma unroll
        for (int e = 0; e < 8; ++e) { const f32x2 b = bb[(dir * 64 + st) * 16 + h0 + e]; o[e] = im ? (w.x * b.y + w.y * b.x) : (w.x * b.x - w.y * b.y); }
        u32x4 w4; w4.x = pk2(o[0], o[1]); w4.y = pk2(o[2], o[3]); w4.z = pk2(o[4], o[5]); w4.w = pk2(o[6], o[7]);
        *(u32x4*)(B1 + (size_t)j * 512 + kv * 8) = w4;
    }
    __syncthreads();
}
struct TJob { const float* src; const float* sc; bf16* dst; int ld, dpitch; };
constexpr int I_IN = 16 * 48, I_OUT = 16 * 32, I_GLU = 8 * 16, I_GU = 16 * 256, I_DN = 16 * 128, I_L = I_IN + I_OUT + I_GLU + I_GU + I_DN;
__device__ __forceinline__ void tjob_decode(Frame& F, int it, TJob& j) {
    const int l = it / I_L; int r = it % I_L; unsigned char* wl = F.ws + WS_W + (size_t)l * WL_SIZE;
    if (r < I_IN) { const int kb = r / 48, nb = r % 48, P0 = nb * 32, pn = P0 >> 8, pp = P0 & 255, bj = pp >> 7, wc = (pp & 127) >> 5, col0 = 256 * pn + 64 * wc + 32 * bj;
        j.src = PINP(2) + (size_t)l * DM * INC + (size_t)(kb * 64) * INC + col0; j.ld = INC; j.sc = PINP(1) + l * DM + kb * 64; j.dst = (bf16*)(wl + WL_WIN) + (size_t)P0 * DM + kb * 64; j.dpitch = DM; return; } r -= I_IN;
    if (r < I_OUT) { const int kb = r / 32, nb = r % 32;
        j.src = PINP(19) + (size_t)l * DM * DM + (size_t)(kb * 64) * DM + nb * 32; j.ld = DM; j.sc = PINP(18) + l * DM + kb * 64; j.dst = (bf16*)(wl + WL_WOUT) + (size_t)nb * 32 * DM + kb * 64; j.dpitch = DM; return; } r -= I_OUT;
    if (r < I_GLU) { const int kb = r / 16, nb = r % 16;
        j.src = PINP(16) + (size_t)l * CW * CW + (size_t)(kb * 64) * CW + nb * 32; j.ld = CW; j.sc = nullptr; j.dst = (bf16*)(wl + WL_WGLU) + (size_t)nb * 32 * CW + kb * 64; j.dpitch = CW; return; } r -= I_GLU;
    if (r < I_GU) { const int e = r >> 8, q = r & 255, kb = q >> 4, nb = q & 15, P0 = nb * 32, half = P0 >> 8, pp = P0 & 255, isup = pp >> 7, f0 = half * 128 + (pp & 127);
        j.src = PINP(isup ? 26 : 25) + ((size_t)l * NEXP + e) * DM * DEXP + (size_t)(kb * 64) * DEXP + f0; j.ld = DEXP; j.sc = PINP(20) + l * DM + kb * 64; j.dst = (bf16*)(wl + WL_WGU) + ((size_t)e * 512 + P0) * DM + kb * 64; j.dpitch = DM; return; } r -= I_GU;
    { const int e = r >> 7, q = r & 127, kb = q >> 5, nb = q & 31;
        j.src = PINP(27) + ((size_t)l * NEXP + e) * DEXP * DM + (size_t)(kb * 64) * DM + nb * 32; j.ld = DM; j.sc = nullptr; j.dst = (bf16*)(wl + WL_WDN) + ((size_t)e * DM + nb * 32) * DEXP + kb * 64; j.dpitch = DEXP; }
}
#define TLOAD(j, v, f) do { _Pragma("unroll") for (int i = 0; i < 8; ++i) { v[i] = *(const f32x4*)(j.src + (size_t)(8 * i + (lane >> 3)) * j.ld + (lane & 7) * 4); f[i] = j.sc ? j.sc[8 * i + (lane >> 3)] : 1.f; } } while (0)
#define TFIN(j, v, f) do { \
    _Pragma("unroll") for (int i = 0; i < 8; ++i) { const int kk = 8 * i + (lane >> 3); LAS float* d = scr + kk * 33 + (lane & 7) * 4; d[0] = v[i].x * f[i]; d[1] = v[i].y * f[i]; d[2] = v[i].z * f[i]; d[3] = v[i].w * f[i]; } \
    asm volatile("s_waitcnt lgkmcnt(0)" ::: "memory"); \
    _Pragma("unroll") for (int j4 = 0; j4 < 4; ++j4) { const int n = (lane >> 3) + 8 * j4, c = lane & 7; const LAS float* s = scr + (8 * c) * 33 + n; \
        u32x4 o; o.x = pk2(s[0 * 33], s[1 * 33]); o.y = pk2(s[2 * 33], s[3 * 33]); o.z = pk2(s[4 * 33], s[5 * 33]); o.w = pk2(s[6 * 33], s[7 * 33]); \
        *(u32x4*)(j.dst + (size_t)n * j.dpitch + 8 * c) = o; } \
    asm volatile("s_waitcnt lgkmcnt(0)" ::: "memory"); } while (0)
template <int PART> __device__ __forceinline__ void phase_prep(Frame& F) {
    __syncthreads();
    {   const int wg = (int)blockIdx.x - (PART && F.G >= 2 * NG * 4 ? NG * 4 : 0);
        if (wg >= 0) for (int job = wg + PART * NG * 4; job < (PART + 1) * NG * 4; job += F.G) s5_prep(F, job >> 7, (job >> 2) & 31, job & 3); }
    if (PART == 0 && blockIdx.x >= 240 && F.tid < 64) {
        f32x2* rt = (f32x2*)(F.ws + WS_ROPE);
        for (int i = (blockIdx.x - 240) * 64 + F.tid; i < 1024; i += 1024) { const int pos = i >> 4, f = i & 15; const float inv = powf(10000.f, -(float)f / 16.f); const float ang = (float)pos * inv; rt[i] = (f32x2){cosf(ang), sinf(ang)}; }
    }
    if (PART == 0) {
        for (int e = (int)blockIdx.x * NTHR + F.tid; e < DEPTH * 48 * DM; e += F.G * NTHR) {
            const int l = e / (48 * DM), i = e % (48 * DM), rho = i / DM, k = i % DM, q = 8 * (rho >> 4) + ((rho & 15) >> 1), part = rho & 1; unsigned o = 0u;
            if (q < 20) { const float w = PINP(20)[l * DM + k] * (q < 4 ? PINP(21)[((size_t)l * DM + k) * 4 + q] : PINP(23)[((size_t)l * DM + k) * 16 + (q - 4)]); const unsigned hb = f2bf(w); o = part ? f2bf(w - bf2f(hb)) : hb; }
            ((bf16*)(F.ws + WS_W + (size_t)l * WL_SIZE + WL_WR))[i] = (bf16)o; }
    }
    if (PART == 0 && blockIdx.x >= 1 && blockIdx.x <= 2) {
        const int l = blockIdx.x - 1;
        unsigned char* wl = F.ws + WS_W + (size_t)l * WL_SIZE;
        LAS float* qk = (LAS float*)F.lds;
        if (F.tid < 256) { const int which = F.tid >> 6, d = F.tid & 63; const float gv_ = PINP(3 + which)[l * HD + d]; ((float*)(wl + WL_QKG))[F.tid] = gv_; qk[F.tid] = gv_; }
        if (F.tid < 4) ((float*)(wl + WL_SINK))[F.tid] = PINP(7)[l * 4 + F.tid] * LOG2E;
        __syncthreads();
        if (F.tid == 0) { float gq = 0.f, gk = 0.f; for (int d = 0; d < HD; ++d) { gq = fmaxf(gq, fabsf(qk[d])); gk = fmaxf(gk, fabsf(qk[64 + d])); }
            ((float*)(wl + WL_SINK))[8] = fmaxf(0.f, 64.f * QSCALE * 1.02f * gq * gk - 20.f);
            float gqb = 0.f, gkb = 0.f; for (int d = 0; d < HD; ++d) { gqb = fmaxf(gqb, fabsf(qk[128 + d])); gkb = fmaxf(gkb, fabsf(qk[192 + d])); }
            ((float*)(wl + WL_SINK))[9] = fmaxf(0.f, 64.f * QSCALE * 1.02f * gqb * gkb - 20.f); }
        ((float*)(wl + WL_GLUB))[F.tid] = PINP(17)[l * CW + F.tid];
        if (F.tid < 20) ((float*)(wl + WL_RB))[F.tid] = F.tid < 4 ? PINP(22)[l * 4 + F.tid] : PINP(24)[l * 16 + F.tid - 4];
    }
    if (PART == 0 && F.tid == 0) ((unsigned*)F.ws)[7168 + blockIdx.x] = (unsigned)__builtin_amdgcn_s_getreg((3 << 11) | 20) & 0xFu;
    LAS float* scr = (LAS float*)(F.lds + F.wave * 16384);
    __syncthreads();
    const int gw = F.vcu * NWAVES + F.wave, NGW = F.G * NWAVES;
    const bool heavy = F.G == 256 && (PART == 0 ? blockIdx.x < 128 : blockIdx.x >= 128);
    const int cw = (((int)blockIdx.x & 127) * NWAVES + F.wave);
    constexpr int N1 = 2 * I_L - I_IN;
    {
        const int lane = F.lane;
        auto item_of = [&](int k_) -> int {
            int it0;
            if (PART == 0 || F.G != 256) { it0 = gw + k_ * NGW; if (it0 >= (PART == 0 ? I_IN : N1)) return -1; }
            else { if (heavy) { if (k_ >= 6) return -1; it0 = 8192 + cw + 1024 * k_; } else { if (k_ >= 8) return -1; it0 = cw + 1024 * k_; } if (it0 >= N1) return -1; }
            return PART == 0 ? it0 : it0 + I_IN; };
        TJob ja, jb, jc; f32x4 va[8], vb[8], vc[8]; float fa[8], fb[8], fc[8];
        int k_ = 0; int ia = item_of(0), ib = item_of(1), ic = -1;
        if (ia >= 0) { tjob_decode(F, ia, ja); TLOAD(ja, va, fa); }
        if (ib >= 0) { tjob_decode(F, ib, jb); TLOAD(jb, vb, fb); }
        while (ia >= 0) {
            ic = item_of(k_ + 2);
            if (ic >= 0) { tjob_decode(F, ic, jc); TLOAD(jc, vc, fc); }
            TFIN(ja, va, fa);
            if (ib < 0) break;
            ia = item_of(k_ + 3);
            if (ia >= 0) { tjob_decode(F, ia, ja); TLOAD(ja, va, fa); }
            TFIN(jb, vb, fb);
            if (ic < 0) break;
            ib = item_of(k_ + 4);
            if (ib >= 0) { tjob_decode(F, ib, jb); TLOAD(jb, vb, fb); }
            TFIN(jc, vc, fc);
            k_ += 3;
        }
    }
    if (PART != 0) { asm volatile("s_waitcnt lgkmcnt(0)" ::: "memory"); __syncthreads(); return; }
    bf16* XB = (bf16*)(F.ws + WS_XB); float* SS = (float*)(F.ws + WS_SSQX);
    const float* x0 = PINP(0);
    for (int k_ = 0; ; ++k_) {
        int m0;
        if (F.G != 256) { m0 = (gw + k_ * NGW) * 4; if (m0 >= T) break; }
        else { if (heavy) { if (k_ >= 3) break; m0 = (5120 + cw + 1024 * k_) * 4; } else { if (k_ >= 5) break; m0 = (cw + 1024 * k_) * 4; } }
        f32x4 v[4][4];
#pragma unroll
        for (int r = 0; r < 4; ++r) { const f32x4* xr = (const f32x4*)(x0 + (size_t)(m0 + r) * DM) + F.lane;
#pragma unroll
            for (int j = 0; j < 4; ++j) v[r][j] = xr[64 * j]; }
#pragma unroll
        for (int r = 0; r < 4; ++r) { float s = 0.f;
#pragma unroll
            for (int j = 0; j < 4; ++j) s += (v[r][j].x * v[r][j].x + v[r][j].y * v[r][j].y) + (v[r][j].z * v[r][j].z + v[r][j].w * v[r][j].w);
            s = wave_sum(s);
            u32x2* o8 = (u32x2*)(XB + (size_t)(m0 + r) * DM) + F.lane;
#pragma unroll
            for (int j = 0; j < 4; ++j) o8[64 * j] = (u32x2){pk2(v[r][j].x, v[r][j].y), pk2(v[r][j].z, v[r][j].w)};
            if (F.lane < 16) SS[(size_t)(m0 + r) * 16 + F.lane] = F.lane == 0 ? s : 0.f; }
    }
}

struct SchedGrid {
    unsigned A, B; unsigned lda, ldb; unsigned strideA, strideB; int nM, nN, nt, nbatch, G, c;
    __device__ __forceinline__ bool next(int i, g8::Unit& u) const {
        const int L = i * G + c, per = nM * nN; if (L >= per * nbatch) return false;
        const int g = L / per; int pm, pn; g8::tile_order(L % per, nM, nN, pm, pn);
        u.A = A + (unsigned)g * strideA + (unsigned)pm * 256u * lda; u.B = B + (unsigned)g * strideB + (unsigned)pn * 256u * ldb; u.lda = lda; u.ldb = ldb; u.nt = nt; u.fin = 1; u.rows = nullptr; u.nv = 0; u.pm = pm; u.pn = pn; u.a0 = g; u.r0 = 0; u.kind = 0; u.dep = -1; u.B2 = 0; return true;
    }
};
template <bool NOSTORE> struct EpiInProjT {
    unsigned char* ws; int l; const LAS f32x2* rope_lds;
    __device__ __forceinline__ void operator()(f32x4 (&acc)[2][2][4][2], const g8::Unit& u, int wr, int wc, int fr, int fq, LAS unsigned char* es) const {
        const int pn = u.pn;
        const float* ssqx = (const float*)(ws + WS_SSQX); const LAS f32x2* rope = rope_lds;
        LAS float* r1s = (LAS float*)es;
        {   const int ln = fr + 16 * fq;
            f32x4 q0[4], q1[4];
            const f32x4* p0 = (const f32x4*)(ssqx + (size_t)(u.pm * 256 + wr * 64 + ln) * 16); const f32x4* p1 = (const f32x4*)(ssqx + (size_t)(u.pm * 256 + 128 + wr * 64 + ln) * 16);
#pragma unroll
            for (int i = 0; i < 4; ++i) { q0[i] = p0[i]; q1[i] = p1[i]; }
            float a0 = 0.f, a1 = 0.f;
#pragma unroll
            for (int i = 0; i < 4; ++i) { a0 += (q0[i].x + q0[i].y) + (q0[i].z + q0[i].w); a1 += (q1[i].x + q1[i].y) + (q1[i].z + q1[i].w); }
            r1s[ln] = rsqrtf(a0 * (1.f / DM) + EPS); r1s[64 + ln] = rsqrtf(a1 * (1.f / DM) + EPS);
            asm volatile("s_waitcnt lgkmcnt(0)" ::: "memory"); }
        const float* gq = (const float*)(ws + WS_W + (size_t)l * WL_SIZE + WL_QKG);
        bf16* QA = (bf16*)(ws + WS_QA); bf16* KA = (bf16*)(ws + WS_KA); bf16* VA = (bf16*)(ws + WS_VA); bf16* QB = (bf16*)(ws + WS_QB); bf16* KB = (bf16*)(ws + WS_KB); bf16* VB = (bf16*)(ws + WS_VB); bf16* UX = (bf16*)(ws + WS_UX);
        int kind; const float* g = nullptr; bf16* dst = nullptr; int pitch = 0, hcol = 0;
        if (pn == 0) { kind = 0; g = gq; dst = QA; pitch = 256; hcol = wc * 64; }
        else if (pn == 1) { if (wc < 2) { kind = 1; g = gq + 64; dst = KA; pitch = 128; hcol = wc * 64; } else { kind = 4; dst = VA; pitch = 128; hcol = (wc - 2) * 64; } }
        else if (pn == 2) { kind = 2; g = gq + 128; dst = QB; pitch = 256; hcol = wc * 64; }
        else if (pn == 3) { if (wc < 2) { kind = 3; g = gq + 192; dst = KB; pitch = 128; hcol = wc * 64; } else { kind = 4; dst = VB; pitch = 128; hcol = (wc - 2) * 64; } }
        else kind = 5;
        f32x4 gv[2][2];
        if (kind < 4) {
#pragma unroll
            for (int bj = 0; bj < 2; ++bj)
#pragma unroll
                for (int n = 0; n < 2; ++n) gv[bj][n] = *(const f32x4*)(g + 32 * bj + 8 * fq + 4 * n);
        }
#pragma unroll
        for (int ai = 0; ai < 2; ++ai)
#pragma unroll
            for (int m = 0; m < 4; ++m) {
                const int row = u.pm * 256 + ai * 128 + wr * 64 + m * 16 + fr;
                const float r1 = r1s[64 * ai + 16 * m + fr];
                f32x4 v[2][2];
#pragma unroll
                for (int bj = 0; bj < 2; ++bj)
#pragma unroll
                    for (int n = 0; n < 2; ++n) v[bj][n] = acc[ai][bj][m][n] * r1;
                if (kind < 4) {
                    float ss = 0.f;
#pragma unroll
                    for (int bj = 0; bj < 2; ++bj)
#pragma unroll
                        for (int n = 0; n < 2; ++n) ss += (v[bj][n].x * v[bj][n].x + v[bj][n].y * v[bj][n].y) + (v[bj][n].z * v[bj][n].z + v[bj][n].w * v[bj][n].w);
                    ss = sum_xor32(sum_xor16(ss));
                    const float rn = rsqrtf(ss * (1.f / HD) + EPS);
#pragma unroll
                    for (int bj = 0; bj < 2; ++bj)
#pragma unroll
                        for (int n = 0; n < 2; ++n) v[bj][n] = v[bj][n] * rn * gv[bj][n];
                    if (kind < 2) {
                        const int tt = row & (SEQ - 1);
#pragma unroll
                        for (int bj = 0; bj < 2; ++bj) {
                            const int pos = bj == 0 ? (tt >> 6) : (tt & 63);
                            const LAS f32x4* rp = (const LAS f32x4*)(rope + pos * 16 + 8 * (fq & 1));
#pragma unroll
                            for (int n = 0; n < 2; ++n) {
                                const f32x4 cs0 = rp[2 * n], cs1 = rp[2 * n + 1];
                                f32x4 pv; const bool up = fq >= 2;
                                pv.x = other_xor32(v[bj][n].x, up); pv.y = other_xor32(v[bj][n].y, up); pv.z = other_xor32(v[bj][n].z, up); pv.w = other_xor32(v[bj][n].w, up);
                                const f32x4 cc = (f32x4){cs0.x, cs0.z, cs1.x, cs1.z}, sn = (f32x4){cs0.y, cs0.w, cs1.y, cs1.w};
                                v[bj][n] = (fq < 2) ? (v[bj][n] * cc - pv * sn) : (pv * sn + v[bj][n] * cc);
                            }
                        }
                    }
                    if (kind == 0 || kind == 2) {
#pragma unroll
                        for (int bj = 0; bj < 2; ++bj)
#pragma unroll
                            for (int n = 0; n < 2; ++n) v[bj][n] = v[bj][n] * QSCALE;
                    }
                }
                if (kind < 5) {
#pragma unroll
                    for (int bj = 0; bj < 2; ++bj) {
                        u32x4 w; w.x = pk2(v[bj][0].x, v[bj][0].y); w.y = pk2(v[bj][0].z, v[bj][0].w); w.z = pk2(v[bj][1].x, v[bj][1].y); w.w = pk2(v[bj][1].z, v[bj][1].w);
                        if (NOSTORE) asm volatile("" :: "v"(w)); else *(u32x4*)(dst + (size_t)row * pitch + hcol + 32 * bj + 8 * fq) = w;
                    }
                } else {
                    const int b = row >> 12, tt = row & (SEQ - 1), c = tt >> 5, s = tt & 31;
#pragma unroll
                    for (int bj = 0; bj < 2; ++bj) {
                        const int col = 256 * (pn - 4) + 64 * wc + 32 * bj + 8 * fq, g_ = col >> 4, h0 = col & 15;
                        u32x4 w; w.x = pk2(v[bj][0].x, v[bj][0].y); w.y = pk2(v[bj][0].z, v[bj][0].w); w.z = pk2(v[bj][1].x, v[bj][1].y); w.w = pk2(v[bj][1].z, v[bj][1].w);
                        if (NOSTORE) asm volatile("" :: "v"(w)); else *(u32x4*)(UX + ((size_t)g_ * 1024 + b * NCH + c) * UXP + s * GC + h0) = w;
                    }
                }
            }
    }
};
typedef EpiInProjT<false> EpiInProj;
__device__ __forceinline__ void phase_inproj(Frame& F, int l) {
    unsigned char* wl = F.ws + WS_W + (size_t)l * WL_SIZE;
    SchedGrid S{(unsigned)WS_XB, (unsigned)(WS_W + (size_t)l * WL_SIZE + WL_WIN), DM * 2, DM * 2, 0, 0, T / 256, INC / 256, DM / 64, 1, F.G, (int)blockIdx.x};
    {   const f32x4* src = (const f32x4*)(F.ws + WS_ROPE); LAS f32x4* dst = (LAS f32x4*)(F.lds + LDS_ROPE);
        __syncthreads();
        for (int i = F.tid; i < 512; i += NTHR) dst[i] = src[i];
        __syncthreads(); }
    EpiInProj E{F.ws, l, (const LAS f32x2*)(F.lds + LDS_ROPE)};
    g8::gemm_phase(F.lds, F.tid, F.ws, S, E);
}

#if defined(PROBE_SET)
struct EpiNone { __device__ __forceinline__ void operator()(f32x4 (&acc)[2][2][4][2], const g8::Unit& u, int wr, int wc, int fr, int fq, LAS unsigned char* es) const {
#pragma unroll
        for (int a = 0; a < 2; ++a)
#pragma unroll
            for (int b = 0; b < 2; ++b)
#pragma unroll
                for (int m = 0; m < 4; ++m) asm volatile("" :: "v"(acc[a][b][m][0]), "v"(acc[a][b][m][1])); } };
__device__ __forceinline__ void phase_inproj_noepi(Frame& F, int l) {
    SchedGrid S{(unsigned)WS_XB, (unsigned)(WS_W + (size_t)l * WL_SIZE + WL_WIN), DM * 2, DM * 2, 0, 0, T / 256, INC / 256, DM / 64, 1, F.G, (int)blockIdx.x};
    EpiNone E{};
    g8::gemm_phase(F.lds, F.tid, F.ws, S, E);
}
__device__ __forceinline__ void phase_inproj_nostore(Frame& F, int l) {
    SchedGrid S{(unsigned)WS_XB, (unsigned)(WS_W + (size_t)l * WL_SIZE + WL_WIN), DM * 2, DM * 2, 0, 0, T / 256, INC / 256, DM / 64, 1, F.G, (int)blockIdx.x};
    EpiInProjT<true> E{F.ws, l, (const LAS f32x2*)(F.lds + LDS_ROPE)};
    g8::gemm_phase(F.lds, F.tid, F.ws, S, E);
}
#endif


namespace att {
using bf16x8 = __attribute__((ext_vector_type(8))) short;
using s16x4 = __attribute__((ext_vector_type(4))) short;
using f32x16 = __attribute__((ext_vector_type(16))) float;
using u32x4 = __attribute__((ext_vector_type(4))) unsigned;
constexpr int NW = 8, QBLK = 32, QB = QBLK * NW, KVBLK = 64;
constexpr int QP = 256, KP = 128, OP = 1024;
__device__ __forceinline__ int crow(int r, int hi) { return (r & 3) + 8 * (r >> 2) + 4 * hi; }
#define SBAR() __builtin_amdgcn_sched_barrier(0)
constexpr int NSLOT = 3, SLOTB = 8192;
constexpr int LDS_K = 0, LDS_V = NSLOT * SLOTB, LDS_WS = 2 * NSLOT * SLOTB, LDS_OST = LDS_WS + NW * 64 * 4, LDS_ATT = LDS_OST + NW * 4096;
__device__ __forceinline__ void glds16(const void* gsrc, unsigned lds_dst) { unsigned keep;
    asm volatile("s_mov_b32 %0, m0\n\ts_mov_b32 m0, %2\n\ts_nop 0\n\tglobal_load_lds_dwordx4 %1, off\n\ts_mov_b32 m0, %0" : "=&s"(keep) : "v"(gsrc), "s"(lds_dst) : "memory"); }
__device__ __forceinline__ float max3f(float a, float b, float c) { float r; asm("v_max3_f32 %0, %1, %2, %3" : "=v"(r) : "v"(a), "v"(b), "v"(c)); return r; }
__device__ __forceinline__ float max2f(float a, float b) { float r; asm("v_max_f32_e32 %0, %1, %2" : "=v"(r) : "v"(a), "v"(b)); return r; }
__device__ __forceinline__ float fadd_s(float a, float b) { float r; asm("v_add_f32_e32 %0, %1, %2" : "=v"(r) : "v"(a), "v"(b)); return r; }
__device__ __forceinline__ float fsub_s(float a, float b) { float r; asm("v_sub_f32_e32 %0, %1, %2" : "=v"(r) : "v"(a), "v"(b)); return r; }
typedef float f32x2_t __attribute__((ext_vector_type(2))); typedef __bf16 bf16x2_t __attribute__((ext_vector_type(2)));
__device__ __forceinline__ unsigned cvtpk_s(float lo, float hi) { f32x2_t v = {lo, hi}; bf16x2_t b = __builtin_convertvector(v, bf16x2_t); return __builtin_bit_cast(unsigned, b); }
#define WAIT_BAR(N) asm volatile("s_waitcnt vmcnt(" #N ") lgkmcnt(0)\n\ts_barrier" ::: "memory")
__device__ __forceinline__ void qkt(f32x16& p0, f32x16& p1, const char* Kslot, const bf16x8* qr, const f32x16& negm, int r32, int hi) {
    const char* kb = Kslot + hi * 1024 + r32 * 16;
#pragma unroll
    for (int d0 = 0; d0 < 4; ++d0) {
        const bf16x8 b0 = *reinterpret_cast<const bf16x8*>(kb + d0 * 2048);
        const bf16x8 b1 = *reinterpret_cast<const bf16x8*>(kb + d0 * 2048 + 512);
        if (d0 == 0) { p0 = __builtin_amdgcn_mfma_f32_32x32x16_bf16(b0, qr[0], negm, 0, 0, 0); p1 = __builtin_amdgcn_mfma_f32_32x32x16_bf16(b1, qr[0], negm, 0, 0, 0); }
        else { p0 = __builtin_amdgcn_mfma_f32_32x32x16_bf16(b0, qr[d0], p0, 0, 0, 0); p1 = __builtin_amdgcn_mfma_f32_32x32x16_bf16(b1, qr[d0], p1, 0, 0, 0); } }
}
typedef __attribute__((address_space(3))) const char* lds_cptr;
typedef short v4i16_t __attribute__((ext_vector_type(4)));
__device__ __forceinline__ void kload8(bf16x8* kf, lds_cptr kp) {
    kf[0] = *(const __attribute__((address_space(3))) bf16x8*)(kp);        kf[1] = *(const __attribute__((address_space(3))) bf16x8*)(kp + 512);
    kf[2] = *(const __attribute__((address_space(3))) bf16x8*)(kp + 2048); kf[3] = *(const __attribute__((address_space(3))) bf16x8*)(kp + 2560);
    kf[4] = *(const __attribute__((address_space(3))) bf16x8*)(kp + 4096); kf[5] = *(const __attribute__((address_space(3))) bf16x8*)(kp + 4608);
    kf[6] = *(const __attribute__((address_space(3))) bf16x8*)(kp + 6144); kf[7] = *(const __attribute__((address_space(3))) bf16x8*)(kp + 6656);
}
__device__ __forceinline__ void kload2(bf16x8* kf, lds_cptr kp, int j) { kf[2 * j] = *(const __attribute__((address_space(3))) bf16x8*)(kp + j * 2048); kf[2 * j + 1] = *(const __attribute__((address_space(3))) bf16x8*)(kp + j * 2048 + 512); }
__device__ __forceinline__ s16x4 vtr(lds_cptr p) { return __builtin_bit_cast(s16x4, __builtin_amdgcn_ds_read_tr16_b64_v4i16((__attribute__((address_space(3))) v4i16_t*)p)); }
__device__ __forceinline__ float rowmax(const f32x16& p0, const f32x16& p1) {
    float a = max3f(p0[0], p0[1], p1[0]), b = max3f(p0[2], p0[3], p1[1]); a = max3f(a, p1[2], p1[3]);
#pragma unroll
    for (int r = 4; r < 16; r += 4) { a = max3f(a, p0[r], p0[r + 1]); b = max3f(b, p0[r + 2], p0[r + 3]); a = max3f(a, p1[r], p1[r + 1]); b = max3f(b, p1[r + 2], p1[r + 3]); }
    const float m = max2f(a, b);
    auto rr = __builtin_amdgcn_permlane32_swap(__float_as_uint(m), __float_as_uint(m), false, false);
    return max2f(__uint_as_float(rr[0]), __uint_as_float(rr[1]));
}
__device__ __forceinline__ void bmask(f32x16& p0, f32x16& p1, int kq, float slope2, float mhat) {
    const float fk = (float)kq;
#pragma unroll
    for (int r = 0; r < 16; ++r) {
        const float d0 = fk + (float)((r & 3) + 8 * (r >> 2)), d1 = d0 + 32.f;
        const float a0 = __builtin_fabsf(d0), a1 = __builtin_fabsf(d1);
        p0[r] = a0 <= 128.f ? p0[r] - __builtin_fmaf(slope2, a0, mhat) : -INFINITY;
        p1[r] = a1 <= 128.f ? p1[r] - __builtin_fmaf(slope2, a1, mhat) : -INFINITY;
    }
}
__device__ __forceinline__ void pv(f32x16* o, int vb, bf16x8 pa0, bf16x8 pa1, bf16x8 pa2, bf16x8 pa3) {
#pragma unroll
    for (int d0 = 0; d0 < 2; ++d0) { s16x4 lo[4], hi[4];
#pragma unroll
        for (int ks = 0; ks < 4; ++ks) {
            asm volatile("ds_read_b64_tr_b16 %0,%1 offset:%c2" : "=&v"(lo[ks]) : "v"(vb), "i"(d0 * 4096 + ks * 1024) : "memory");
            asm volatile("ds_read_b64_tr_b16 %0,%1 offset:%c2" : "=&v"(hi[ks]) : "v"(vb), "i"(d0 * 4096 + ks * 1024 + 512) : "memory"); }
        asm volatile("s_waitcnt lgkmcnt(0)" ::: "memory"); SBAR();
#define PK(k) (bf16x8){lo[k][0], lo[k][1], lo[k][2], lo[k][3], hi[k][0], hi[k][1], hi[k][2], hi[k][3]}
        o[d0] = __builtin_amdgcn_mfma_f32_32x32x16_bf16(pa0, PK(0), o[d0], 0, 0, 0);
        o[d0] = __builtin_amdgcn_mfma_f32_32x32x16_bf16(pa1, PK(1), o[d0], 0, 0, 0);
        o[d0] = __builtin_amdgcn_mfma_f32_32x32x16_bf16(pa2, PK(2), o[d0], 0, 0, 0);
        o[d0] = __builtin_amdgcn_mfma_f32_32x32x16_bf16(pa3, PK(3), o[d0], 0, 0, 0);
#undef PK
    }
}

template <int MODE, int THRL>
__device__ __forceinline__ void attn_unit(const int tid  , int b, int h, int qb, const bf16* Q, const bf16* __restrict__ K, const bf16* __restrict__ V, bf16* O, float* SSQ, float slope2, float sink2, float bound_m0, char* shm) {
    int lane; asm volatile("v_mbcnt_lo_u32_b32 %0, -1, 0\n\tv_mbcnt_hi_u32_b32 %0, -1, %0" : "=v"(lane));
    const int r32 = lane & 31, hi = lane >> 5; const int wid = __builtin_amdgcn_readfirstlane(tid >> 6);
    constexpr int UNITQ = MODE == 1 ? 128 : QB; const int wrow = MODE == 1 ? (wid & 3) : wid;
    const long rowbase = (long)b * SEQ; const int q0 = qb * UNITQ;
    const bf16* Qw = Q + (rowbase + q0 + wrow * QBLK) * QP + h * 64;
    int t0 = 0, NT = SEQ / KVBLK;
    if (MODE == 1) { t0 = 2 * qb - 2; if (t0 < 0) t0 = 0; int t1 = 2 * qb + 4; if (t1 > SEQ / KVBLK) t1 = SEQ / KVBLK; NT = t1 - t0; }
    const bf16* Kh = K + (rowbase + (long)t0 * KVBLK) * KP + (h >> 1) * 64; const bf16* Vh = V + (rowbase + (long)t0 * KVBLK) * KP + (h >> 1) * 64;
    const unsigned lds0 = (unsigned)(uintptr_t)shm;
    float* wsf = (float*)(shm + LDS_WS) + wid * 64;
    const bf16* ksrc = Kh + (long)lane * KP + wid * 8;
    const bf16* vsrc = Vh + (long)(16 * (wid & 3) + (lane >> 2)) * KP + (wid >> 2) * 32 + (lane & 3) * 8;
    const unsigned kdst = lds0 + LDS_K + wid * 1024, vdst = lds0 + LDS_V + wid * 1024;
#define DMA_K(t, slot) glds16(ksrc + (long)(t) * KVBLK * KP, (unsigned)__builtin_amdgcn_readfirstlane(kdst + (slot)))
#define DMA_V(t, slot) glds16(vsrc + (long)(t) * KVBLK * KP, (unsigned)__builtin_amdgcn_readfirstlane(vdst + (slot)))
    const int vb0 = (int)(lds0 + LDS_V) + ((lane >> 4) & 1) * 32 + (lane & 3) * 8 + (4 * hi + ((lane & 15) >> 2)) * 64;
    const char* Kbase = shm + LDS_K; bf16x8 kf[8];
    const lds_cptr shm3 = (lds_cptr)shm; const lds_cptr kp0 = shm3 + LDS_K + hi * 1024 + r32 * 16; const lds_cptr vp0 = shm3 + LDS_V + ((lane >> 4) & 1) * 32 + (lane & 3) * 8 + (4 * hi + ((lane & 15) >> 2)) * 64;
    DMA_K(0, 0); DMA_V(0, 0); DMA_K(1, SLOTB);
    bf16x8 qr[4];
#pragma unroll
    for (int d0 = 0; d0 < 4; ++d0) qr[d0] = *reinterpret_cast<const bf16x8*>(&Qw[(long)r32 * QP + d0 * 16 + hi * 8]);
    float mhat = 0.f, l_reg = 0.f; f32x16 o[2]; o[0] = f32x16{}; o[1] = f32x16{}; f32x16 negm = f32x16{};
    if (MODE == 1) { mhat = bound_m0; l_reg = hi == 0 ? __builtin_amdgcn_exp2f(sink2 - bound_m0) : 0.f; }
    if (MODE == 0) { _Pragma("unroll") for (int r = 0; r < 16; ++r) negm[r] = -sink2; asm volatile("" : "+v"(negm)); }
#define NEGM (MODE == 0 ? negm : f32x16{})
    const int kq0 = t0 * KVBLK + 4 * hi - (q0 + wrow * QBLK + r32);
#define CMASK(P0, P1, t) do { if (MODE == 1) bmask(P0, P1, kq0 + (t) * KVBLK, slope2, mhat); } while (0)
    bool resc = false;
#define DECIDE(C0, C1) do { if (false) { \
      float rm = rowmax(C0, C1); resc = false; \
      if (__builtin_expect(__any(rm > (float)THRL), 0)) { const float dl = __builtin_fmaxf(rm, 0.f); mhat += dl; \
        _Pragma("unroll") for (int r = 0; r < 16; ++r) { C0[r] -= dl; C1[r] -= dl; } \
        if (MODE == 0) { _Pragma("unroll") for (int r = 0; r < 16; ++r) negm[r] = -mhat; asm volatile("" : "+v"(negm)); } \
        const float f = __builtin_amdgcn_exp2f(-dl); l_reg *= f; if (hi == 0) wsf[r32] = f; resc = true; } } } while (0)
#define START(P0, P1) do { const float rm = rowmax(P0, P1); resc = false; \
    { const float dl = rm; mhat = fadd_s(mhat, dl); \
      _Pragma("unroll") for (int r = 0; r < 16; ++r) { P0[r] = fsub_s(P0[r], dl); P1[r] = fsub_s(P1[r], dl); } \
      _Pragma("unroll") for (int r = 0; r < 16; ++r) negm[r] = -mhat; asm volatile("" : "+v"(negm)); } } while (0)
#define RESC() do { if (false && resc) { asm volatile("s_waitcnt lgkmcnt(0)" ::: "memory"); \
      _Pragma("unroll") for (int d_ = 0; d_ < 2; ++d_) _Pragma("unroll") for (int r = 0; r < 16; ++r) o[d_][r] *= wsf[crow(r, hi)]; } } while (0)
    f32x16 pA0, pA1, pB0, pB1;
    int sl_prev = 0, sl_cur = 0, sl_next = SLOTB;
#define ROT() do { sl_prev = sl_cur; sl_cur = sl_next; sl_next = (sl_next == (NSLOT - 1) * SLOTB) ? 0 : sl_next + SLOTB; } while (0)
    DMA_K(2, 2 * SLOTB);
    WAIT_BAR(3);
    qkt(pA0, pA1, Kbase, qr, NEGM, r32, hi); asm volatile("s_nop 15\n\ts_nop 7" : "+v"(pA0), "+v"(pA1));
    if (MODE == 1) { CMASK(pA0, pA1, 0); DECIDE(pA0, pA1); }
#pragma unroll
    for (int r = 0; r < 16; ++r) { pA0[r] = __builtin_amdgcn_exp2f(pA0[r]); pA1[r] = __builtin_amdgcn_exp2f(pA1[r]); }
    WAIT_BAR(0);
    DMA_K(3, 0); DMA_V(1, SLOTB);
    ROT();
    kload8(kf, kp0 + sl_cur);
    WAIT_BAR(2);
    s16x4 vlo[8], vhi[8]; u32x4 pw0, pw1, pw2, pw3;
#define PKW(P, B) cvtpk_s(P[B], P[B + 1])
#define PAF(k) __builtin_bit_cast(bf16x8, pw##k)
#define VFR(i) (bf16x8){vlo[i][0], vlo[i][1], vlo[i][2], vlo[i][3], vhi[i][0], vhi[i][1], vhi[i][2], vhi[i][3]}
#define PIN(x) asm volatile("" : "+v"(x))
#define GAPA(MF, A0, A1, A2, A3, W0, W1, PW) do { MF; sacc += A0; sacc += A1; sacc += A2; sacc += A3; PIN(sacc); W0; W1; PIN(PW); SBAR(); } while (0)
#define EX(v) __builtin_amdgcn_exp2f(v)
#define GAPB(MF, X, B) do { MF; X[B] = EX(X[B]); X[B + 1] = EX(X[B + 1]); X[B + 2] = EX(X[B + 2]); X[B + 3] = EX(X[B + 3]); PIN(X); SBAR(); } while (0)
#define VRD(i) do { vlo[i] = vtr(vp_ + (((i) >> 2) * 4096 + ((i) & 3) * 1024)); vhi[i] = vtr(vp_ + (((i) >> 2) * 4096 + ((i) & 3) * 1024 + 512)); } while (0)
#define KRD(G, j) do { if (G) { kload2(kf, kp0 + sl_next, j); SBAR(); } } while (0)
#define STEP(C0, C1, P0, P1, t, GK, GV, GL) do { SBAR(); \
    const lds_cptr vp_ = vp0 + sl_prev; \
    VRD(0); SBAR(); float sacc = (P0[0] + P0[1]); \
    GAPA(C0 = __builtin_amdgcn_mfma_f32_32x32x16_bf16(kf[0], qr[0], NEGM, 0, 0, 0), P0[2], P0[3], P0[4], P0[5],     pw0[0] = PKW(P0, 0), pw0[1] = PKW(P0, 2), pw0); \
    VRD(4); SBAR(); GAPA(C1 = __builtin_amdgcn_mfma_f32_32x32x16_bf16(kf[1], qr[0], NEGM, 0, 0, 0), P0[6], P0[7], P0[8], P0[9],     pw0[2] = PKW(P0, 4), pw0[3] = PKW(P0, 6), pw0); \
    VRD(1); SBAR(); GAPA(C0 = __builtin_amdgcn_mfma_f32_32x32x16_bf16(kf[2], qr[1], C0, 0, 0, 0),   P0[10], P0[11], P0[12], P0[13], pw1[0] = PKW(P0, 8), pw1[1] = PKW(P0, 10), pw1); \
    VRD(5); SBAR(); GAPA(C1 = __builtin_amdgcn_mfma_f32_32x32x16_bf16(kf[3], qr[1], C1, 0, 0, 0),   P0[14], P0[15], P1[0], P1[1],   pw1[2] = PKW(P0, 12), pw1[3] = PKW(P0, 14), pw1); \
    VRD(2); SBAR(); GAPA(C0 = __builtin_amdgcn_mfma_f32_32x32x16_bf16(kf[4], qr[2], C0, 0, 0, 0),   P1[2], P1[3], P1[4], P1[5],     pw2[0] = PKW(P1, 0), pw2[1] = PKW(P1, 2), pw2); \
    VRD(6); SBAR(); GAPA(C1 = __builtin_amdgcn_mfma_f32_32x32x16_bf16(kf[5], qr[2], C1, 0, 0, 0),   P1[6], P1[7], P1[8], P1[9],     pw2[2] = PKW(P1, 4), pw2[3] = PKW(P1, 6), pw2); \
    VRD(3); SBAR(); GAPA(C0 = __builtin_amdgcn_mfma_f32_32x32x16_bf16(kf[6], qr[3], C0, 0, 0, 0),   P1[10], P1[11], P1[12], P1[13], pw3[0] = PKW(P1, 8), pw3[1] = PKW(P1, 10), pw3); \
    VRD(7); SBAR(); GAPA(C1 = __builtin_amdgcn_mfma_f32_32x32x16_bf16(kf[7], qr[3], C1, 0, 0, 0),   P1[14], P1[15], 0.f, 0.f,       pw3[2] = PKW(P1, 12), pw3[3] = PKW(P1, 14), pw3); \
    l_reg += sacc; \
    if (GK) { DMA_K((t) + 3, sl_cur); } if (GV) { DMA_V((t) + 1, sl_next); } \
    CMASK(C0, C1, t); \
    DECIDE(C0, C1); \
    SBAR(); \
    GAPB(o[0] = __builtin_amdgcn_mfma_f32_32x32x16_bf16(PAF(0), VFR(0), o[0], 0, 0, 0), C0, 0); \
    GAPB(o[1] = __builtin_amdgcn_mfma_f32_32x32x16_bf16(PAF(0), VFR(4), o[1], 0, 0, 0), C0, 4); \
    KRD(GL, 0); GAPB(o[0] = __builtin_amdgcn_mfma_f32_32x32x16_bf16(PAF(1), VFR(1), o[0], 0, 0, 0), C0, 8); \
    KRD(GL, 1); GAPB(o[1] = __builtin_amdgcn_mfma_f32_32x32x16_bf16(PAF(1), VFR(5), o[1], 0, 0, 0), C0, 12); \
    KRD(GL, 2); GAPB(o[0] = __builtin_amdgcn_mfma_f32_32x32x16_bf16(PAF(2), VFR(2), o[0], 0, 0, 0), C1, 0); \
    KRD(GL, 3); GAPB(o[1] = __builtin_amdgcn_mfma_f32_32x32x16_bf16(PAF(2), VFR(6), o[1], 0, 0, 0), C1, 4); \
    GAPB(o[0] = __builtin_amdgcn_mfma_f32_32x32x16_bf16(PAF(3), VFR(3), o[0], 0, 0, 0), C1, 8); \
    GAPB(o[1] = __builtin_amdgcn_mfma_f32_32x32x16_bf16(PAF(3), VFR(7), o[1], 0, 0, 0), C1, 12); \
    } while (0)
    int t = 1;
    for (; t + 5 < NT; t += 2) {
        STEP(pB0, pB1, pA0, pA1, t, true, true, true);     WAIT_BAR(2); RESC(); ROT();
        STEP(pA0, pA1, pB0, pB1, t + 1, true, true, true); WAIT_BAR(2); RESC(); ROT();
    }
#define ENDW(tt) do { if ((tt) + 3 < NT) { WAIT_BAR(2); } else if ((tt) + 2 < NT) { WAIT_BAR(1); } else { WAIT_BAR(0); } } while (0)
    for (; t + 1 < NT; t += 2) {
        STEP(pB0, pB1, pA0, pA1, t, (t + 3 < NT), (t + 1 < NT), (t + 1 < NT));       ENDW(t);     RESC(); ROT();
        STEP(pA0, pA1, pB0, pB1, t + 1, (t + 4 < NT), (t + 2 < NT), (t + 2 < NT));   ENDW(t + 1); RESC(); ROT();
    }
    STEP(pB0, pB1, pA0, pA1, NT - 1, false, false, false); RESC();
    { float sacc = pB0[0] + pB0[1];
#pragma unroll
      for (int r = 2; r < 16; ++r) sacc += pB0[r];
#pragma unroll
      for (int r = 0; r < 16; ++r) sacc += pB1[r];
      l_reg += sacc;
      pw0 = (u32x4){PKW(pB0, 0), PKW(pB0, 2), PKW(pB0, 4), PKW(pB0, 6)}; pw1 = (u32x4){PKW(pB0, 8), PKW(pB0, 10), PKW(pB0, 12), PKW(pB0, 14)};
      pw2 = (u32x4){PKW(pB1, 0), PKW(pB1, 2), PKW(pB1, 4), PKW(pB1, 6)}; pw3 = (u32x4){PKW(pB1, 8), PKW(pB1, 10), PKW(pB1, 12), PKW(pB1, 14)};
      SBAR(); pv(o, vb0 + sl_cur, PAF(0), PAF(1), PAF(2), PAF(3)); }
#undef PKW
#undef PAF
#undef VFR
#undef PIN
#undef GAPA
#undef GAPB
#undef EX
#undef VRD
#undef KRD
#undef STEP
#undef ENDW
    { auto rr = __builtin_amdgcn_permlane32_swap(__float_as_uint(l_reg), __float_as_uint(l_reg), false, false); l_reg = __uint_as_float(rr[0]) + __uint_as_float(rr[1]); }
    if (hi == 0) wsf[32 + r32] = l_reg; asm volatile("s_waitcnt lgkmcnt(0)" ::: "memory");
    float rli[16];
#pragma unroll
    for (int r = 0; r < 16; ++r) rli[r] = __builtin_amdgcn_rcpf(wsf[32 + crow(r, hi)]);
    const long orow0 = rowbase + q0 + wrow * QBLK;
    bf16* Ow = O + orow0 * OP + h * 64;
    { bf16* stg = (bf16*)(shm + LDS_OST) + wid * 2048;
#pragma unroll
      for (int r = 0; r < 16; ++r) { const int orow = crow(r, hi);
#pragma unroll
        for (int d0 = 0; d0 < 2; ++d0) stg[orow * 64 + d0 * 32 + r32] = (bf16)f2bf(o[d0][r] * rli[r]); }
      asm volatile("s_waitcnt lgkmcnt(0)" ::: "memory");
#pragma unroll
      for (int i = 0; i < 4; ++i) { const int row = i * 8 + (lane >> 3), ch = lane & 7; const u32x4 v = *(const u32x4*)(stg + row * 64 + ch * 8);
        *(u32x4*)(Ow + (long)row * OP + ch * 8) = v;
        float ss = 0.f;
#pragma unroll
        for (int e = 0; e < 4; ++e) { const float a = bf2f(v[e] & 0xffffu), c = bf2f(v[e] >> 16); ss += a * a + c * c; }
        ss = sum8(ss);
        if (ch == 0) SSQ[(orow0 + row) * 4 + h] = ss; } }
    asm volatile("s_waitcnt lgkmcnt(0)\n\ts_barrier" ::: "memory");
#undef NEGM
#undef DMA_K
#undef DMA_V
#undef CMASK
#undef DECIDE
#undef START
#undef RESC
#undef ROT
}
#undef SBAR
#undef WAIT_BAR
}

struct EpiXend {
    float* xend;
    __device__ __forceinline__ void operator()(f32x4 (&acc)[2][2][4][2], const g8::Unit& u, int wr, int wc, int fr, int fq, LAS unsigned char* es) const {
#pragma unroll
        for (int ai = 0; ai < 2; ++ai)
#pragma unroll
            for (int m = 0; m < 4; ++m) { const int row = u.pm * 256 + ai * 128 + wr * 64 + m * 16 + fr; float* rp = xend + ((size_t)u.a0 * 1024 + row) * 256 + wc * 32 + 8 * fq;
#pragma unroll
                for (int bj = 0; bj < 2; ++bj)
#pragma unroll
                    for (int n = 0; n < 2; ++n) *(f32x4*)(rp + bj * 128 + 4 * n) = acc[ai][bj][m][n]; }
    }
};

__device__ __forceinline__ void phase_attn_a(Frame& F, int l) {
    unsigned char* ws = F.ws;
    const float m0a = ((const float*)(ws + WS_W + (size_t)l * WL_SIZE + WL_SINK))[8];
    char* shm = F.ldsg;
    for (int i = 0; i < (F.G == 256 ? 2 : 512); ++i) {
        int bk, w;
        if (F.G == 256) { bk = (F.vcu >> 5) * 2 + i; w = F.vcu & 31; }
        else { const int u = F.vcu + i * F.G; if (u >= 512) break; bk = u >> 5; w = u & 31; }
        const int b = bk >> 1, h = (bk & 1) * 2 + (w >> 4), qb = w & 15;
        att::attn_unit<0, 8>(F.tid, b, h, qb, (const bf16*)(ws + WS_QA), (const bf16*)(ws + WS_KA), (const bf16*)(ws + WS_VA), (bf16*)(ws + WS_MIX), (float*)(ws + WS_SSQA), 0.f, m0a, 0.f, shm);
    }
}
__device__ __forceinline__ void phase_attn_b(Frame& F, int l) {
    unsigned char* ws = F.ws; unsigned char* wl = ws + WS_W + (size_t)l * WL_SIZE;
    char* shm = F.ldsg;
    for (int i = 0; i < (F.G == 256 ? 3 : 512); ++i) {
        int b, u;
        if (F.G == 256) { const int sub = F.vcu & 31; b = F.vcu >> 5; if (sub < 16) u = i * 16 + sub; else { if (i > 0) break; u = 48 + (sub - 16); } }
        else { const int uu = F.vcu + i * F.G; if (uu >= 512) break; b = uu >> 6; u = uu & 63; }
        const int kvh = u >> 5, qb = u & 31, h = kvh * 2 + (F.wave >> 2);
        const float slope2 = exp2f(-2.f * (float)(h + 1)) * LOG2E; const float sink2 = ((const float*)(wl + WL_SINK))[h];
        att::attn_unit<1, 8>(F.tid, b, h, qb, (const bf16*)(ws + WS_QB), (const bf16*)(ws + WS_KB), (const bf16*)(ws + WS_VB), (bf16*)(ws + WS_MIX) + 256, (float*)(ws + WS_SSQB), slope2, sink2, fmaxf(((const float*)(wl + WL_SINK))[9], fmaxf(sink2 - 20.f, 0.f)), shm);
    }
}

#define SCAN_LOAD(g, b, dir, xr, xi) do { const size_t rowb_ = (size_t)(g) * 1024 + (b) * NCH; \
        _Pragma("unroll") for (int i = 0; i < 16; ++i) { const int cc = kg * 16 + i, c = (dir) ? (NCH - 1 - cc) : cc; const float* q = XE + (rowb_ + c) * 256 + (dir) * 128 + p; xr[i] = q[0]; xi[i] = q[64]; } } while (0)
__device__ __forceinline__ void scan_finish(Frame& F, int l, int g, int b, int dir, float (&xr)[16], float (&xi)[16]) {
    unsigned char* ws = F.ws; unsigned char* wl = ws + WS_W + (size_t)l * WL_SIZE;
    bf16* UX = (bf16*)(ws + WS_UX);
    LAS f32x2* E = (LAS f32x2*)F.lds;
    const int p = F.tid & 63, kg = F.tid >> 6;
    {
        const f32x2 a1 = ((const f32x2*)(wl + WL_A32))[(dir * NG + g) * 64 + p];
        const size_t rowb = (size_t)g * 1024 + b * NCH;
#pragma unroll
        for (int i = 1; i < 16; ++i) { const float nr = a1.x * xr[i - 1] - a1.y * xi[i - 1] + xr[i], ni = a1.x * xi[i - 1] + a1.y * xr[i - 1] + xi[i]; xr[i] = nr; xi[i] = ni; }
        __syncthreads();
        E[kg * 64 + p] = (f32x2){xr[15], xi[15]};
        __syncthreads();
        f32x2 a16 = a1;
#pragma unroll
        for (int i = 0; i < 4; ++i) a16 = (f32x2){a16.x * a16.x - a16.y * a16.y, 2.f * a16.x * a16.y};
        float cr = 0.f, ci = 0.f;
        for (int j = 0; j < kg; ++j) { const f32x2 e = E[j * 64 + p]; const float nr = a16.x * cr - a16.y * ci + e.x, ni = a16.x * ci + a16.y * cr + e.y; cr = nr; ci = ni; }
        float pr_ = 1.f, pi_ = 0.f;
#pragma unroll
        for (int i = 0; i < 16; ++i) {
            float er, ei;
            if (i == 0) { er = cr; ei = ci; }
            else { er = xr[i - 1] + (pr_ * cr - pi_ * ci); ei = xi[i - 1] + (pr_ * ci + pi_ * cr); }
            const int cc = kg * 16 + i, c = dir ? (NCH - 1 - cc) : cc;
            bf16* q = UX + (rowb + c) * UXP + 512 + dir * 128 + p;
            q[0] = (bf16)f2bf(er); q[64] = (bf16)f2bf(ei);
            const float npr = pr_ * a1.x - pi_ * a1.y, npi = pr_ * a1.y + pi_ * a1.x; pr_ = npr; pi_ = npi;
        }
    }
}
constexpr int CW_DEP2 = 12800;
__device__ __forceinline__ void phase_s5a(Frame& F, int l) {
    unsigned char* ws = F.ws;
    const int sub = F.vcu & 31; if (sub >= 16) return;
    const int idx = (F.vcu >> 5) * 16 + sub;
    SchedGrid S{(unsigned)WS_UX, (unsigned)(WS_W + (size_t)l * WL_SIZE + WL_S5B1), UXP * 2, 512 * 2, 1024u * UXP * 2u, 256u * 512u * 2u, 4, 1, 8, NG, 1 << 20, idx};
    EpiXend E{(float*)(ws + WS_XEND)};
    g8::gemm_phase(F.lds, F.tid, F.ws, S, E);
    if (idx >= NG * 4) return;
    asm volatile("s_waitcnt vmcnt(0)" ::: "memory");
    __syncthreads();
    if (F.wave == 0) { __builtin_amdgcn_fence(__ATOMIC_ACQUIRE, "agent"); asm volatile("s_waitcnt vmcnt(0)" ::: "memory"); }
    __syncthreads();
    const int g = idx >> 2, pm = idx & 3;
    {
        const float* XE = (const float*)(ws + WS_XEND); const int p = F.tid & 63, kg = F.tid >> 6;
        float ar[16], ai[16], br[16], bi[16];
        SCAN_LOAD(g, 2 * pm, 0, ar, ai); SCAN_LOAD(g, 2 * pm, 1, br, bi);
        scan_finish(F, l, g, 2 * pm, 0, ar, ai); SCAN_LOAD(g, 2 * pm + 1, 0, ar, ai);
        scan_finish(F, l, g, 2 * pm, 1, br, bi); SCAN_LOAD(g, 2 * pm + 1, 1, br, bi);
        scan_finish(F, l, g, 2 * pm + 1, 0, ar, ai);
        scan_finish(F, l, g, 2 * pm + 1, 1, br, bi); }
    asm volatile("s_waitcnt vmcnt(0)" ::: "memory");
    __syncthreads();
    if (F.tid == 0) { __builtin_amdgcn_fence(__ATOMIC_RELEASE, "agent"); asm volatile("s_waitcnt vmcnt(0)" ::: "memory");
        __hip_atomic_fetch_add((unsigned*)ws + CW_DEP2 + l * 128 + idx, 32u, __ATOMIC_RELAXED, __HIP_MEMORY_SCOPE_AGENT); }
}
__device__ __forceinline__ float gelu_tanh_f(float v) {
    const float w = __builtin_fmaf(v * v, -2.302208198f * 0.044715f, -2.302208198f);
    return v * __builtin_amdgcn_rcpf(1.f + __builtin_amdgcn_exp2f(v * w));
}
struct EpiS5Y {
    bf16* yc;
    __device__ __forceinline__ void operator()(f32x4 (&acc)[2][2][4][2], const g8::Unit& u, int wr, int wc, int fr, int fq, LAS unsigned char* es) const {
        const int g = u.a0;
#pragma unroll
        for (int ai = 0; ai < 2; ++ai)
#pragma unroll
            for (int m = 0; m < 4; ++m) { const int R = u.pm * 256 + ai * 128 + wr * 64 + m * 16 + fr, b = R >> 7, c = R & 127;
#pragma unroll
                for (int bj = 0; bj < 2; ++bj) { const int n = u.pn * 256 + bj * 128 + wc * 32 + 8 * fq, tl = n >> 4, h0 = n & 15;
                    const size_t tok = (size_t)b * SEQ + c * CH + tl; const f32x4 v0 = acc[ai][bj][m][0], v1 = acc[ai][bj][m][1];
                    u32x4 w; w.x = pk2(gelu_tanh_f(v0.x), gelu_tanh_f(v0.y)); w.y = pk2(gelu_tanh_f(v0.z), gelu_tanh_f(v0.w)); w.z = pk2(gelu_tanh_f(v1.x), gelu_tanh_f(v1.y)); w.w = pk2(gelu_tanh_f(v1.z), gelu_tanh_f(v1.w));
                    *(u32x4*)(yc + tok * CW + g * GC + h0) = w; } }
    }
};
struct SchedS5b {
    unsigned A, B; int l, sb;
    __device__ __forceinline__ bool next(int i, g8::Unit& u) const {
        if (sb < 0 || i >= 2) return false;
        const int L = 2 * sb + i; if (L >= NG * 8) return false;
        const int g = L >> 3, pm = (L & 7) >> 1, pn = L & 1;
        u.A = A + (unsigned)g * (1024u * UXP * 2u) + (unsigned)pm * 256u * (UXP * 2u); u.B = B + (unsigned)g * (512u * UXP * 2u) + (unsigned)pn * 256u * (UXP * 2u); u.lda = UXP * 2; u.ldb = UXP * 2; u.nt = 12; u.fin = 1;
        u.rows = nullptr; u.nv = 0; u.pm = pm; u.pn = pn; u.a0 = g; u.r0 = 0; u.kind = 0; u.dep = CW_DEP2 + l * 128 + g * 4 + pm; u.B2 = 0; return true;
    }
};
__device__ __forceinline__ void phase_s5b(Frame& F, int l) {
    unsigned char* ws = F.ws;
    const int sub = F.vcu & 31;
    SchedS5b S{(unsigned)WS_UX, (unsigned)(WS_W + (size_t)l * WL_SIZE + WL_S5B2), l, sub >= 16 ? (F.vcu >> 5) * 16 + (sub - 16) : -1};
    EpiS5Y E{(bf16*)(ws + WS_YC)};
    g8::gemm_phase(F.lds, F.tid, F.ws, S, E);
}

struct EpiGlu {
    unsigned char* ws; int l;
    __device__ __forceinline__ void operator()(f32x4 (&acc)[2][2][4][2], const g8::Unit& u, int wr, int wc, int fr, int fq, LAS unsigned char* es) const {
        const bf16* yc = (const bf16*)(ws + WS_YC); bf16* mix = (bf16*)(ws + WS_MIX); float* ssc = (float*)(ws + WS_SSQC);
        const float* gb = (const float*)(ws + WS_W + (size_t)l * WL_SIZE + WL_GLUB);
        f32x4 bv[2][2];
#pragma unroll
        for (int bj = 0; bj < 2; ++bj)
#pragma unroll
            for (int n = 0; n < 2; ++n) bv[bj][n] = *(const f32x4*)(gb + u.pn * 256 + bj * 128 + wc * 32 + 8 * fq + 4 * n);
#pragma unroll
        for (int ai = 0; ai < 2; ++ai) {
            u32x4 yv[4][2];
#pragma unroll
            for (int m = 0; m < 4; ++m)
#pragma unroll
                for (int bj = 0; bj < 2; ++bj) yv[m][bj] = *(const u32x4*)(yc + ((size_t)u.pm * 256 + ai * 128 + wr * 64 + m * 16 + fr) * CW + u.pn * 256 + bj * 128 + wc * 32 + 8 * fq);
#pragma unroll
            for (int m = 0; m < 4; ++m) { const size_t row = (size_t)u.pm * 256 + ai * 128 + wr * 64 + m * 16 + fr; float ss = 0.f;
#pragma unroll
                for (int bj = 0; bj < 2; ++bj) { const int col = u.pn * 256 + bj * 128 + wc * 32 + 8 * fq; float o[8];
#pragma unroll
                    for (int n = 0; n < 2; ++n)
#pragma unroll
                        for (int j = 0; j < 4; ++j) { const float a = acc[ai][bj][m][n][j] + bv[bj][n][j]; const float gate = __builtin_amdgcn_rcpf(1.f + __builtin_amdgcn_exp2f(-a * LOG2E));
                            const unsigned yw = yv[m][bj][n * 2 + (j >> 1)]; const float y = bf2f((j & 1) ? (yw >> 16) : (yw & 0xffffu)); o[n * 4 + j] = y * gate; }
                    u32x4 w; w.x = pk2(o[0], o[1]); w.y = pk2(o[2], o[3]); w.z = pk2(o[4], o[5]); w.w = pk2(o[6], o[7]);
                    *(u32x4*)(mix + row * 1024 + 512 + col) = w;
#pragma unroll
                    for (int e = 0; e < 4; ++e) { const float a = bf2f(w[e] & 0xffffu), c = bf2f(w[e] >> 16); ss += a * a + c * c; } }
                ss = sum_xor32(sum_xor16(ss));
                if (fq == 0) ssc[row * 8 + u.pn * 4 + wc] = ss; } }
    }
};
__device__ __forceinline__ void phase_glu(Frame& F, int l) {
    unsigned char* ws = F.ws; unsigned char* wl = ws + WS_W + (size_t)l * WL_SIZE;
    SchedGrid S{(unsigned)WS_YC, (unsigned)(WS_W + (size_t)l * WL_SIZE + WL_WGLU), CW * 2, CW * 2, 0, 0, T / 256, 2, 8, 1, F.G, (int)blockIdx.x};
    EpiGlu E{ws, l};
    g8::gemm_phase(F.lds, F.tid, F.ws, S, E);
}

struct SchedOutProj {
    unsigned A, B; int G, c;
    __device__ __forceinline__ bool next(int i, g8::Unit& u) const {
        const int j = i / 3, seg = i - 3 * j, L = j * G + c; int pm, pn; if (!g8::tile_order(L, T / 256, DM / 256, pm, pn)) return false;
        const unsigned off = seg == 0 ? 0u : (seg == 1 ? 512u : 1024u);
        u.A = A + (unsigned)pm * 256u * 2048u + off; u.B = B + (unsigned)pn * 256u * 2048u + off; u.lda = 2048; u.ldb = 2048; u.nt = seg == 2 ? 8 : 4; u.fin = seg == 2; u.rows = nullptr; u.nv = 0; u.pm = pm; u.pn = pn; u.a0 = seg; u.r0 = 0; u.kind = 0; u.dep = -1; u.B2 = 0; return true;
    }
};
struct EpiOutProj {
    unsigned char* ws;
    __device__ __forceinline__ void operator()(f32x4 (&acc)[2][2][4][2], const g8::Unit& u, int wr, int wc, int fr, int fq, LAS unsigned char* es) const {
        const float* ssa = (const float*)(ws + WS_SSQA); const float* ssb = (const float*)(ws + WS_SSQB); const float* ssc = (const float*)(ws + WS_SSQC);
        bf16* xb = (bf16*)(ws + WS_XB);
        const int seg = u.a0;
        LAS float* fs = (LAS float*)es;
        if (seg == 0) {
            const int ln = fr + 16 * fq;
#pragma unroll
            for (int h = 0; h < 2; ++h) { const size_t row = (size_t)u.pm * 256 + h * 128 + wr * 64 + ln;
                const f32x4 a = *(const f32x4*)(ssa + row * 4), b = *(const f32x4*)(ssb + row * 4), c0 = *(const f32x4*)(ssc + row * 8), c1 = *(const f32x4*)(ssc + row * 8 + 4);
                const float ma = ((a.x + a.y) + (a.z + a.w)) * (1.f / 256.f) + EPS, mb = ((b.x + b.y) + (b.z + b.w)) * (1.f / 256.f) + EPS, mc = (((c0.x + c0.y) + (c0.z + c0.w)) + ((c1.x + c1.y) + (c1.z + c1.w))) * (1.f / 512.f) + EPS;
                const float ra = rsqrtf(ma), rb = rsqrtf(mb), rc = rsqrtf(mc);
                fs[64 * h + ln] = ra * sqrtf(mb); fs[128 + 64 * h + ln] = rb * sqrtf(mc); fs[256 + 64 * h + ln] = rc; }
            asm volatile("s_waitcnt lgkmcnt(0)" ::: "memory");
        }
        if (seg < 2) {
#pragma unroll
            for (int ai = 0; ai < 2; ++ai)
#pragma unroll
                for (int m = 0; m < 4; ++m) { const float f = fs[128 * seg + 64 * ai + 16 * m + fr];
#pragma unroll
                    for (int bj = 0; bj < 2; ++bj)
#pragma unroll
                        for (int n = 0; n < 2; ++n) acc[ai][bj][m][n] = acc[ai][bj][m][n] * f; }
        } else {
#pragma unroll
            for (int ai = 0; ai < 2; ++ai) {
                u32x4 xo[4][2];
#pragma unroll
                for (int m = 0; m < 4; ++m)
#pragma unroll
                    for (int bj = 0; bj < 2; ++bj) xo[m][bj] = *(const u32x4*)(xb + ((size_t)u.pm * 256 + ai * 128 + wr * 64 + m * 16 + fr) * DM + u.pn * 256 + bj * 128 + wc * 32 + 8 * fq);
#pragma unroll
                for (int m = 0; m < 4; ++m) { const size_t row = (size_t)u.pm * 256 + ai * 128 + wr * 64 + m * 16 + fr; const float f = fs[256 + 64 * ai + 16 * m + fr];
#pragma unroll
                    for (int bj = 0; bj < 2; ++bj) { const size_t off = row * DM + u.pn * 256 + bj * 128 + wc * 32 + 8 * fq; const u32x4 x = xo[m][bj];
                        const f32x4 x0 = (f32x4){bf2f(x.x & 0xffffu), bf2f(x.x >> 16), bf2f(x.y & 0xffffu), bf2f(x.y >> 16)}, x1 = (f32x4){bf2f(x.z & 0xffffu), bf2f(x.z >> 16), bf2f(x.w & 0xffffu), bf2f(x.w >> 16)};
                        const f32x4 v0 = x0 + acc[ai][bj][m][0] * f, v1 = x1 + acc[ai][bj][m][1] * f;
                        u32x4 w; w.x = pk2(v0.x, v0.y); w.y = pk2(v0.z, v0.w); w.z = pk2(v1.x, v1.y); w.w = pk2(v1.z, v1.w);
                        *(u32x4*)(xb + off) = w; } } }
        }
    }
};
__device__ __forceinline__ void phase_outproj(Frame& F, int l) {
    unsigned char* ws = F.ws; unsigned char* wl = ws + WS_W + (size_t)l * WL_SIZE;
    SchedOutProj S{(unsigned)WS_MIX, (unsigned)(WS_W + (size_t)l * WL_SIZE + WL_WOUT), F.G, (int)blockIdx.x};
    EpiOutProj E{ws};
    g8::gemm_phase(F.lds, F.tid, F.ws, S, E);
}


constexpr size_t WS_TOKB = 6 * MiB;
constexpr size_t WS_TOKR = 6 * MiB + 128 * 1024;
constexpr size_t WS_R2 = 6 * MiB + 256 * 1024;
constexpr size_t WS_TOKW = 6 * MiB + 384 * 1024;
constexpr size_t WS_CNT = 6 * MiB + 640 * 1024;
constexpr size_t WS_BTAB = 6 * MiB + 680 * 1024;
constexpr int BCAP = T;
constexpr size_t WS_ROWG = WS_YTMP;
constexpr size_t WS_ROWW = WS_YTMP + 4 * MiB;
constexpr int CW_BCNT = 8192;
constexpr size_t WS_ACT = WS_QA;
constexpr int NBKT = 24, MAXROWS = T + NBKT * 256;
static_assert((size_t)NBKT * BCAP * 4 <= 4 * MiB && WS_ROWW + (size_t)NBKT * BCAP * 16 <= WS_YTMP + 64 * MiB && (size_t)MAXROWS * 512 * 2 <= 64 * MiB, "moe ws map");

__device__ __forceinline__ void phase_router(Frame& F, int l) {
    unsigned char* ws = F.ws; unsigned char* wl = ws + WS_W + (size_t)l * WL_SIZE;
    constexpr int WP = 2064;
    LAS unsigned char* wimg = F.lds;
    LAS float* lgs = (LAS float*)(F.lds + 48 * WP);
    constexpr int RB0 = 48 * WP + 128 * 20 * 4;
    LAS int* tb = (LAS int*)(F.lds + RB0); LAS f32x2* tw = (LAS f32x2*)(F.lds + RB0 + 512); LAS float* tr2 = (LAS float*)(F.lds + RB0 + 1536);
    {   const u32x4* src = (const u32x4*)(wl + WL_WR); u32x4 wv[12];
#pragma unroll
        for (int k = 0; k < 12; ++k) wv[k] = src[F.tid + k * NTHR];
#pragma unroll
        for (int k = 0; k < 12; ++k) { const int i = F.tid + k * NTHR; *(LAS u32x4*)(wimg + (i >> 7) * WP + (i & 127) * 16) = wv[k]; } }
    const float* rb = (const float*)(wl + WL_RB);
    const bf16* X = (const bf16*)(ws + WS_XB);
    __syncthreads();
    for (int tile = F.vcu; tile < T / 128; tile += F.G) {
        {   const int tk = F.lane & 15, kc = F.lane >> 4;
            const bf16* xrow = X + ((size_t)tile * 128 + F.wave * 16 + tk) * DM + 8 * kc;
            const LAS unsigned char* wrow = wimg + tk * WP + kc * 16;
            f32x4 acc0 = (f32x4){0.f, 0.f, 0.f, 0.f}, acc1 = acc0, acc2 = acc0; float ss = 0.f;
            u32x4 xv2[2][16];
#pragma unroll
            for (int hb = 0; hb < 2; ++hb)
#pragma unroll
                for (int i = 0; i < 16; ++i) xv2[hb][i] = *(const u32x4*)(xrow + (hb * 16 + i) * 32);
#pragma unroll
            for (int hb = 0; hb < 2; ++hb) { u32x4 (&xv)[16] = xv2[hb];
#pragma unroll
                for (int i = 0; i < 16; ++i) { const int ks = hb * 16 + i; const bf16x8 xb8 = __builtin_bit_cast(bf16x8, xv[i]);
                    const bf16x8 w0 = *(const LAS bf16x8*)(wrow + ks * 64), w1 = *(const LAS bf16x8*)(wrow + 16 * WP + ks * 64), w2 = *(const LAS bf16x8*)(wrow + 32 * WP + ks * 64);
                    acc0 = __builtin_amdgcn_mfma_f32_16x16x32_bf16(w0, xb8, acc0, 0, 0, 0); acc1 = __builtin_amdgcn_mfma_f32_16x16x32_bf16(w1, xb8, acc1, 0, 0, 0); acc2 = __builtin_amdgcn_mfma_f32_16x16x32_bf16(w2, xb8, acc2, 0, 0, 0);
#pragma unroll
                    for (int e = 0; e < 4; ++e) { const float a = bf2f(xv[i][e] & 0xffffu), c = bf2f(xv[i][e] >> 16); ss += a * a + c * c; } } }
            ss = sum_xor32(sum_xor16(ss));
            const int ti = F.wave * 16 + tk; LAS float* lr = lgs + ti * 20 + 2 * kc;
            lr[0] = acc0[0] + acc0[1]; lr[1] = acc0[2] + acc0[3]; lr[8] = acc1[0] + acc1[1]; lr[9] = acc1[2] + acc1[3];
            if (kc < 2) { lr[16] = acc2[0] + acc2[1]; lr[17] = acc2[2] + acc2[3]; }
            if (kc == 0) tr2[ti] = rsqrtf(ss * (1.f / DM) + EPS);
        }
        __syncthreads();
        if (F.tid < 128) { const int ti = F.tid; const float r2 = tr2[ti]; const LAS float* lg = lgs + ti * 20;
            float cj[4];
#pragma unroll
            for (int j2 = 0; j2 < 4; ++j2) cj[j2] = lg[j2] * r2 + rb[j2];
            int g = 0; float mx = cj[0];
#pragma unroll
            for (int j2 = 1; j2 < 4; ++j2) if (cj[j2] > mx) { mx = cj[j2]; g = j2; }
            float se = 0.f;
#pragma unroll
            for (int j2 = 0; j2 < 4; ++j2) se += __expf(cj[j2] - mx);
            const float top_p = 1.f / se;
            const float f0 = lg[4 + g * 4] * r2 + rb[4 + g * 4], f1 = lg[5 + g * 4] * r2 + rb[5 + g * 4], f2 = lg[6 + g * 4] * r2 + rb[6 + g * 4], f3 = lg[7 + g * 4] * r2 + rb[7 + g * 4];
            int i1 = 0; float v1 = f0; if (f1 > v1) { v1 = f1; i1 = 1; } if (f2 > v1) { v1 = f2; i1 = 2; } if (f3 > v1) { v1 = f3; i1 = 3; }
            int i2 = -1; float v2 = -3.0e38f;
            if (i1 != 0 && f0 > v2) { v2 = f0; i2 = 0; } if (i1 != 1 && f1 > v2) { v2 = f1; i2 = 1; } if (i1 != 2 && f2 > v2) { v2 = f2; i2 = 2; } if (i1 != 3 && f3 > v2) { v2 = f3; i2 = 3; }
            const float e2 = __expf(v2 - v1); const float w1 = top_p / (1.f + e2), w2 = top_p * e2 / (1.f + e2);
            const int lo = i1 < i2 ? i1 : i2, hi = i1 < i2 ? i2 : i1; const int pr = lo == 0 ? hi - 1 : (lo == 1 ? hi + 1 : 5);
            tb[ti] = g * 6 + pr; tw[ti] = i1 < i2 ? (f32x2){w1, w2} : (f32x2){w2, w1}; }
        __syncthreads();
        LAS int* toff = (LAS int*)(F.lds + RB0 + 2048);
        if (F.tid < 32) { const int b = F.tid; int c = 0; for (int t2 = 0; t2 < 128; ++t2) c += (tb[t2] == b) ? 1 : 0;
            toff[b] = (b < NBKT && c > 0) ? (int)atomicAdd((unsigned*)ws + CW_BCNT + l * 32 + b, (unsigned)c) : 0; }
        int bk = 0, rank = 0;
        if (F.tid < 128) { bk = tb[F.tid]; for (int t2 = 0; t2 < F.tid; ++t2) rank += (tb[t2] == bk) ? 1 : 0; }
        __syncthreads();
        if (F.tid < 128) { const size_t tok = (size_t)tile * 128 + F.tid; const size_t pos = (size_t)bk * BCAP + toff[bk] + rank;
            ((int*)(ws + WS_ROWG))[pos] = (int)tok; const f32x2 w2 = tw[F.tid]; ((f32x4*)(ws + WS_ROWW))[pos] = (f32x4){w2.x, w2.y, tr2[F.tid], 0.f}; }
        __syncthreads();
    }
}
constexpr int LDS_BTAB = LDS_MISC - 16 - 512;
__device__ __forceinline__ void moe_table(Frame& F, int l) {
    LAS int* tabl = (LAS int*)(F.lds + LDS_BTAB);
    __syncthreads();
    if (F.tid < 32) tabl[F.tid] = F.tid < NBKT ? (int)__hip_atomic_load((unsigned*)F.ws + CW_BCNT + l * 32 + F.tid, __ATOMIC_RELAXED, __HIP_MEMORY_SCOPE_AGENT) : 0;
    __syncthreads();
    if (F.tid == 0) { int s = 0; for (int j = 0; j < NBKT; ++j) { tabl[32 + j] = s; s += (tabl[j] + 255) >> 8; } tabl[32 + NBKT] = s; }
    __syncthreads();
}
__device__ __forceinline__ bool moe_bucket(const LAS int* tabl, int pm, int& elo, int& ehi, int& r0, int& nv) {
    if (pm >= tabl[32 + NBKT]) return false;
    int b = 0;
    for (int j = 1; j < NBKT; ++j) b += (tabl[32 + j] <= pm) ? 1 : 0;
    b = __builtin_amdgcn_readfirstlane(b);
    const int lt = pm - __builtin_amdgcn_readfirstlane(tabl[32 + b]), tot = __builtin_amdgcn_readfirstlane(tabl[b]);
    const int g = b / 6, pr = b - 6 * g; const int lo = pr < 3 ? 0 : (pr < 5 ? 1 : 2), hi = pr < 3 ? pr + 1 : (pr < 5 ? pr - 1 : 3);
    elo = g * 4 + lo; ehi = g * 4 + hi; r0 = b * BCAP + lt * 256; nv = tot - lt * 256; if (nv > 256) nv = 256; return true;
}
constexpr int CW_XCC = 7168;
constexpr int CW_DEP = 12288;
struct SchedMoe {
    unsigned char* ws; unsigned wgu, wdn; const LAS int* tabl; int l, G, c;
    __device__ __forceinline__ bool next(int i, g8::Unit& u) const {
        const int MT = __builtin_amdgcn_readfirstlane(tabl[32 + NBKT]);
        const int x = c & 7, cx = c >> 3, W = G >> 3;
        const int mq = MT >> 3, mr = MT & 7, m0 = x * mq + (x < mr ? x : mr), U = 4 * (mq + (x < mr ? 1 : 0));
        int ngu = 0; if (cx < U) ngu = (U - cx + W - 1) / W;
        int off, kind, seg = 0;
        if (i < ngu) { off = i * W + cx; kind = 0; }
        else { const int k = i - ngu; seg = 1; kind = 1;
            int rem = U - 2 * W; rem = rem < 0 ? 0 : rem; if (rem > W - 1) rem = W - 1;
            if (k == 0) off = cx; else { if (cx < rem) return false; off = W + (cx - rem) + (k - 1) * (W - rem); } }
        if (off >= U) return false;
        const int pm = m0 + (off >> 2), pn = off & 3;
        int elo, ehi, r0, nv; if (!moe_bucket(tabl, pm, elo, ehi, r0, nv)) return false;
        if (kind == 0) { const int e = pn < 2 ? elo : ehi;
            u.A = (unsigned)WS_XB; u.rows = (const int*)(ws + WS_ROWG) + r0; u.nv = nv; u.lda = 2048;
            u.B = wgu + ((unsigned)e * 512u + (unsigned)(pn & 1) * 256u) * 2048u; u.ldb = 2048; u.nt = 16; u.fin = 1; u.pm = pm; u.pn = pn; u.a0 = pn; u.r0 = r0; u.kind = 0; u.dep = -1; u.B2 = 0; return true; }
        u.A = (unsigned)WS_ACT + (unsigned)pm * 256u * 1024u; u.rows = nullptr; u.nv = nv; u.lda = 1024;
        u.B = wdn + ((unsigned)elo * 1024u + (unsigned)pn * 256u) * 512u; u.B2 = wdn + ((unsigned)ehi * 1024u + (unsigned)pn * 256u) * 512u; u.ldb = 512; u.nt = 8; u.fin = 1;
        u.pm = pm; u.pn = pn; u.a0 = 1; u.r0 = r0; u.kind = 1; u.dep = CW_DEP + l * 256 + pm; return true;
    }
};
struct EpiGU {
    unsigned char* ws; int l; int samex; int pbx = 0;
    __device__ __forceinline__ void operator()(f32x4 (&acc)[2][2][4][2], const g8::Unit& u, int wr, int wc, int fr, int fq, LAS unsigned char* es) const {
        const f32x4* roww = (const f32x4*)(ws + WS_ROWW) + u.r0;
        const __amdgpu_buffer_rsrc_t rs = __builtin_amdgcn_make_buffer_rsrc((void*)ws, 0, 0x7fffffff, 0x00020000);
        f32x4 rw[2][4];
#pragma unroll
        for (int ai = 0; ai < 2; ++ai)
#pragma unroll
            for (int m = 0; m < 4; ++m) { const int R = ai * 128 + wr * 64 + m * 16 + fr; rw[ai][m] = R < u.nv ? roww[R] : (f32x4){0.f, 0.f, 0.f, 0.f}; }
#pragma unroll
        for (int ai = 0; ai < 2; ++ai)
#pragma unroll
            for (int m = 0; m < 4; ++m) { const int R = ai * 128 + wr * 64 + m * 16 + fr; const size_t pos = (size_t)u.pm * 256 + R;
                const float r2 = rw[ai][m].z, w = (u.a0 >> 1) ? rw[ai][m].y : rw[ai][m].x; float o[8];
#pragma unroll
                for (int n = 0; n < 2; ++n)
#pragma unroll
                    for (int j = 0; j < 4; ++j) { const float gt = acc[ai][0][m][n][j] * r2, up = acc[ai][1][m][n][j] * r2;
                        o[n * 4 + j] = gt * __builtin_amdgcn_rcpf(1.f + __builtin_amdgcn_exp2f(-gt * LOG2E)) * up * w; }
                u32x4 wv; wv.x = pk2(o[0], o[1]); wv.y = pk2(o[2], o[3]); wv.z = pk2(o[4], o[5]); wv.w = pk2(o[6], o[7]);
                const unsigned so = (unsigned)(WS_ACT + (pos * 512 + u.a0 * 128 + wc * 32 + 8 * fq) * 2);
                if (samex || (pbx & 1)) __builtin_amdgcn_raw_buffer_store_b128(wv, rs, so, 0, 0);
                else __builtin_amdgcn_raw_buffer_store_b128(wv, rs, so, 0, 16); }
        if (!(pbx & 2)) asm volatile("s_waitcnt vmcnt(0)" ::: "memory");
        if (fr == 0 && fq == 0) __hip_atomic_fetch_add((unsigned*)ws + CW_DEP + l * 256 + u.pm, 1u, __ATOMIC_RELAXED, __HIP_MEMORY_SCOPE_AGENT);
    }
};
struct EpiDown {
    unsigned char* ws; float* xout;
    __device__ __forceinline__ void operator()(f32x4 (&acc)[2][2][4][2], const g8::Unit& u, int wr, int wc, int fr, int fq, LAS unsigned char* es) const {
        if (u.a0 == 0) return;
        const int* rowg = (const int*)(ws + WS_ROWG) + u.r0; bf16* xb = (bf16*)(ws + WS_XB); float* ssx = (float*)(ws + WS_SSQX);
        int tk[2][4];
#pragma unroll
        for (int ai = 0; ai < 2; ++ai)
#pragma unroll
            for (int m = 0; m < 4; ++m) { const int R = ai * 128 + wr * 64 + m * 16 + fr; tk[ai][m] = R < u.nv ? rowg[R] : -1; }
        const __amdgpu_buffer_rsrc_t rsx = __builtin_amdgcn_make_buffer_rsrc((void*)ws, 0, 0x7fffffff, 0x00020000);
        u32x4 xo2[2][4][2];
#pragma unroll
        for (int ai = 0; ai < 2; ++ai)
#pragma unroll
            for (int m = 0; m < 4; ++m)
#pragma unroll
                for (int bj = 0; bj < 2; ++bj) xo2[ai][m][bj] = __builtin_amdgcn_raw_buffer_load_b128(rsx, (unsigned)WS_XB + ((unsigned)(tk[ai][m] < 0 ? 0 : tk[ai][m]) * (unsigned)DM + (unsigned)(u.pn * 256 + bj * 128 + wc * 32 + 8 * fq)) * 2u, 0, 0);
#pragma unroll
        for (int ai = 0; ai < 2; ++ai) {
            u32x4 (&xo)[4][2] = xo2[ai];
#pragma unroll
            for (int m = 0; m < 4; ++m) { const int tok = tk[ai][m]; float ss = 0.f;
                if (tok >= 0) {
#pragma unroll
                    for (int bj = 0; bj < 2; ++bj) { const size_t off = (size_t)tok * DM + u.pn * 256 + bj * 128 + wc * 32 + 8 * fq; const u32x4 x = xo[m][bj];
                        const f32x4 x0 = (f32x4){bf2f(x.x & 0xffffu), bf2f(x.x >> 16), bf2f(x.y & 0xffffu), bf2f(x.y >> 16)}, x1 = (f32x4){bf2f(x.z & 0xffffu), bf2f(x.z >> 16), bf2f(x.w & 0xffffu), bf2f(x.w >> 16)};
                        const f32x4 v0 = x0 + acc[ai][bj][m][0], v1 = x1 + acc[ai][bj][m][1];
                        if (xout) { *(f32x4*)(xout + off) = v0; *(f32x4*)(xout + off + 4) = v1; }
                        else { u32x4 w; w.x = pk2(v0.x, v0.y); w.y = pk2(v0.z, v0.w); w.z = pk2(v1.x, v1.y); w.w = pk2(v1.z, v1.w);
                            *(u32x4*)(xb + off) = w;
#pragma unroll
                            for (int e = 0; e < 4; ++e) { const float a = bf2f(w[e] & 0xffffu), c = bf2f(w[e] >> 16); ss += a * a + c * c; } } } }
                ss = sum_xor32(sum_xor16(ss));
                if (tok >= 0 && fq == 0) ssx[(size_t)tok * 16 + u.pn * 4 + wc] = ss; } }
    }
};
struct EpiMoe {
    EpiGU gu; EpiDown dn;
    __device__ __forceinline__ void operator()(f32x4 (&acc)[2][2][4][2], const g8::Unit& u, int wr, int wc, int fr, int fq, LAS unsigned char* es) const {
        if (u.kind == 0) gu(acc, u, wr, wc, fr, fq, es); else dn(acc, u, wr, wc, fr, fq, es);
    }
};
__device__ __forceinline__ void phase_moe(Frame& F, int l, int pbx = 0) {
    unsigned char* ws = F.ws;
    moe_table(F, l);
    SchedMoe S{ws, (unsigned)(WS_W + (size_t)l * WL_SIZE + WL_WGU), (unsigned)(WS_W + (size_t)l * WL_SIZE + WL_WDN), (const LAS int*)(F.lds + LDS_BTAB), l, F.G, (int)blockIdx.x};
    int samex;
    {   const unsigned mine = (unsigned)__builtin_amdgcn_s_getreg((3 << 11) | 20) & 0xFu;
        const unsigned v = ((const unsigned*)ws)[CW_XCC + (F.lane & 31) * 8 + ((int)blockIdx.x & 7)];
        samex = (F.G == 256 && __builtin_amdgcn_ballot_w64(v != mine) == 0ull) ? 1 : 0; }
    if (pbx) samex = 0;
    EpiMoe E{EpiGU{ws, l, samex, pbx}, EpiDown{ws, l == DEPTH - 1 ? F.out : nullptr}};
    g8::gemm_phase(F.lds, F.tid, F.ws, S, E);
}

#if defined(PROBE_SET)
struct EpiMoeNone { unsigned char* ws; int l;
    __device__ __forceinline__ void operator()(f32x4 (&acc)[2][2][4][2], const g8::Unit& u, int wr, int wc, int fr, int fq, LAS unsigned char* es) const {
#pragma unroll
        for (int a = 0; a < 2; ++a)
#pragma unroll
            for (int b = 0; b < 2; ++b)
#pragma unroll
                for (int m = 0; m < 4; ++m) asm volatile("" :: "v"(acc[a][b][m][0]), "v"(acc[a][b][m][1])); } };
__device__ __forceinline__ void phase_moe_noepi(Frame& F, int l) {
    unsigned char* ws = F.ws;
    moe_table(F, l);
    SchedMoe S{ws, (unsigned)(WS_W + (size_t)l * WL_SIZE + WL_WGU), (unsigned)(WS_W + (size_t)l * WL_SIZE + WL_WDN), (const LAS int*)(F.lds + LDS_BTAB), l, F.G, (int)blockIdx.x};
    EpiMoeNone E{ws, l};
    g8::gemm_phase(F.lds, F.tid, F.ws, S, E);
}
#endif


constexpr int PH_PREP = 0, PH_PER_LAYER = 10;
constexpr int PL_INPROJ = 0, PL_ATTN = 1, PL_SCAN = 2, PL_S5B = 3, PL_GLU = 4, PL_OUTPROJ = 5, PL_ROUTER = 6, PL_SCATTER = 7, PL_GU = 8, PL_DOWN = 9;
constexpr int N_PHASES = 1 + DEPTH * PH_PER_LAYER;


#define XB_TMO      128
#define XB_XCNT(j)  (256  + 64 * (j))
#define XB_XSUB(j)  (1280 + 64 * (j))
#define XB_XGEN(j)  (2304 + 64 * (j))
#define XB_TOP      3328
#define XB_TOPGEN   3392
#define XCD_BAR_WORDS 3456
#define XB_SPIN_CAP (1u << 20)
__device__ __forceinline__ unsigned xb_ld(unsigned* p)              { return __hip_atomic_load(p, __ATOMIC_RELAXED, __HIP_MEMORY_SCOPE_AGENT); }
__device__ __forceinline__ unsigned xb_add(unsigned* p, unsigned v) { return __hip_atomic_fetch_add(p, v, __ATOMIC_RELAXED, __HIP_MEMORY_SCOPE_AGENT); }
__device__ __forceinline__ unsigned xb_xcc_id() { return (unsigned)__builtin_amdgcn_s_getreg((3 << 11) | 20) & 0xFu; }
#define XB_SPIN(cond, bar) do { unsigned _sp = 0; while (cond) { __builtin_amdgcn_s_sleep(1); \
    if ((++_sp & 255u) == 0u) { if (xb_ld(&(bar)[XB_TMO])) break; if (_sp > XB_SPIN_CAP) { atomicAdd(&(bar)[XB_TMO], 1u); break; } } } } while (0)
struct XcdBarrier { unsigned* bar; unsigned x; volatile LAS unsigned* st; };
__device__ __forceinline__ XcdBarrier xcd_barrier_post(unsigned* bar, volatile LAS unsigned* st, bool leader) {
    XcdBarrier b; b.bar = bar; b.x = xb_xcc_id(); b.st = st;
    if (leader) (void)xb_add(&bar[XB_XCNT(b.x)], 1u);
    return b;
}
__device__ __forceinline__ void xcd_barrier_complete(unsigned* bar, unsigned x, unsigned& nloc, unsigned& nx) {
    const unsigned G = gridDim.x * gridDim.y * gridDim.z;
    unsigned sum, cnt, mine, sp = 0u;
    for (;;) {
        sum = 0u; cnt = 0u; mine = 0u;
#pragma unroll
        for (unsigned j = 0; j < 16; ++j) { const unsigned c = xb_ld(&bar[XB_XCNT(j)]); sum += c; cnt += (c > 0u) ? 1u : 0u; mine = (j == x) ? c : mine; }
        if (sum == G) break;
        __builtin_amdgcn_s_sleep(1);
        if ((++sp & 255u) == 0u) { if (xb_ld(&bar[XB_TMO])) break; if (sp > XB_SPIN_CAP) { atomicAdd(&bar[XB_TMO], 1u); break; } }
    }
    nloc = mine > 0u ? mine : 1u; nx = cnt > 0u ? cnt : 1u;
}
__device__ __forceinline__ void xcd_barrier(const XcdBarrier& b, bool leader) {
    asm volatile("s_waitcnt vmcnt(0)" ::: "memory");
    __syncthreads();
    if (leader) {
        unsigned* bar = b.bar;
        __builtin_amdgcn_s_waitcnt(0);
        unsigned nloc = b.st[0], nx = b.st[1];
        if (nloc == 0u) { xcd_barrier_complete(bar, b.x, nloc, nx); b.st[0] = nloc; b.st[1] = nx; }
        const unsigned old = xb_add(&bar[XB_XSUB(b.x)], 1u);
        const unsigned gen = old / nloc;
        if (old + 1u == (gen + 1u) * nloc) {
            __builtin_amdgcn_fence(__ATOMIC_RELEASE, "agent");
            asm volatile("s_waitcnt vmcnt(0)" ::: "memory");
            const unsigned og = xb_add(&bar[XB_TOP], 1u);
            const unsigned tg = og / nx;
            if (og + 1u == (tg + 1u) * nx) xb_add(&bar[XB_TOPGEN], 1u);
            else XB_SPIN(xb_ld(&bar[XB_TOPGEN]) == tg, bar);
            __builtin_amdgcn_fence(__ATOMIC_ACQUIRE, "agent");
            xb_add(&bar[XB_XGEN(b.x)], 1u);
            asm volatile("s_waitcnt vmcnt(0)" ::: "memory");
        } else {
            XB_SPIN(xb_ld(&bar[XB_XGEN(b.x)]) == gen, bar);
            __builtin_amdgcn_fence(__ATOMIC_ACQUIRE, "agent");
            asm volatile("s_waitcnt vmcnt(0)" ::: "memory");
        }
    }
    __syncthreads();
}
constexpr int LDS_BARST = LDS_MISC - 16;
constexpr size_t CTL_ZERO_BYTES = 64 * 1024;

struct Args { P p; int ph_lo, ph_hi; };

__global__ void __launch_bounds__(NTHR, 2) mk(Args args) {
    extern __shared__ __attribute__((aligned(16))) unsigned char lds_raw[];
    Frame F;
    F.lds = (LAS unsigned char*)lds_raw; F.ldsg = (char*)lds_raw;
    F.tid = threadIdx.x; F.lane = F.tid & 63; F.wave = __builtin_amdgcn_readfirstlane(F.tid >> 6);
    F.G = gridDim.x; { const int bx = blockIdx.x; F.vcu = (F.G % 8 == 0) ? (bx % 8) * (F.G / 8) + bx / 8 : bx; }
    {   LAS unsigned* pw = (LAS unsigned*)(F.lds + LDS_MISC);
        if (threadIdx.x < sizeof(P) / 4) pw[threadIdx.x] = ((const unsigned*)&args.p)[threadIdx.x];
        F.pl = (const LAS P*)pw; }
    if (threadIdx.x < 4) ((LAS unsigned*)(F.lds + LDS_BARST))[threadIdx.x] = 0u;
    __syncthreads();
    const int lo = args.ph_lo, hi = args.ph_hi;
    if (hi - lo > 1) (void)xcd_barrier_post((unsigned*)uniptr(F.pl->ws) + 1024, (volatile LAS unsigned*)(F.lds + LDS_BARST), threadIdx.x == 0);
#define GRID_BAR() do { XcdBarrier bar_; bar_.bar = (unsigned*)uniptr(F.pl->ws) + 1024; bar_.x = xb_xcc_id(); bar_.st = (volatile LAS unsigned*)(F.lds + LDS_BARST); \
        int ln2_; asm volatile("v_mbcnt_lo_u32_b32 %0, -1, 0\n\tv_mbcnt_hi_u32_b32 %0, -1, %0" : "=v"(ln2_)); xcd_barrier(bar_, F.wave == 0 && ln2_ == 0); } while (0)
#define PHASE_ENTER() do { int ln_; asm volatile("v_mbcnt_lo_u32_b32 %0, -1, 0\n\tv_mbcnt_hi_u32_b32 %0, -1, %0" : "=v"(ln_) :: "memory"); F.lane = ln_; F.tid = F.wave * 64 + ln_; \
        F.ws = (unsigned char*)uniptr(F.pl->ws); F.out = (float*)uniptr(F.pl->out); } while (0)
#define RUN(ph, call) do { if (lo <= (ph) && (ph) < hi) { PHASE_ENTER(); call; if ((ph) + 1 < hi) GRID_BAR(); } } while (0)
    RUN(PH_PREP, { phase_prep<1>(F); phase_prep<0>(F); });
#if defined(PROBE_SET)
    if ((PROBE_SET) & (1 << 13)) { PHASE_ENTER(); phase_prep<0>(F); GRID_BAR(); }
    if ((PROBE_SET) & (1 << 14)) { PHASE_ENTER(); phase_inproj(F, 0); GRID_BAR(); }
    if ((PROBE_SET) & (1 << 15)) { PHASE_ENTER(); phase_inproj(F, 0); GRID_BAR(); PHASE_ENTER(); phase_s5a(F, 0); phase_attn_a(F, 0); phase_attn_b(F, 0); GRID_BAR(); }
#endif
#define LAYER(l) do { \
        RUN(1 + (l) * PH_PER_LAYER + PL_INPROJ, phase_inproj(F, (l))); \
        RUN(1 + (l) * PH_PER_LAYER + PL_ATTN, { phase_s5a(F, (l)); phase_attn_a(F, (l)); phase_attn_b(F, (l)); phase_s5b(F, (l)); }); \
        RUN(1 + (l) * PH_PER_LAYER + PL_GLU, phase_glu(F, (l))); \
        RUN(1 + (l) * PH_PER_LAYER + PL_OUTPROJ, phase_outproj(F, (l))); \
        RUN(1 + (l) * PH_PER_LAYER + PL_ROUTER, phase_router(F, (l))); \
        RUN(1 + (l) * PH_PER_LAYER + PL_GU, phase_moe(F, (l))); \
    } while (0)
    LAYER(0);
    LAYER(1);
#if defined(PROBE_SET)
    if (hi == N_PHASES) {
        GRID_BAR();
#define PRB(bit, call) do { if ((PROBE_SET) & (1 << (bit))) { PHASE_ENTER(); call; GRID_BAR(); } } while (0)
        if ((PROBE_SET) & (1 << 19)) { for (int r_ = 0; r_ < 10; ++r_) GRID_BAR(); }
        PRB(0, phase_prep<1>(F));
        PRB(1, phase_inproj(F, 1));
        PRB(16, phase_inproj_noepi(F, 1));
        PRB(17, phase_inproj_nostore(F, 1));
        PRB(2, phase_attn_a(F, 1));
        PRB(3, phase_attn_b(F, 1));
        PRB(4, phase_s5a(F, 1));
        PRB(6, phase_s5b(F, 1));
        PRB(7, phase_glu(F, 1));
        PRB(8, phase_outproj(F, 1));
        PRB(9, phase_router(F, 1));
        PRB(11, phase_moe(F, 0));
        PRB(20, phase_moe_noepi(F, 0));
        PRB(22, phase_moe(F, 0, 3));
        PRB(23, phase_moe(F, 0, 1));
        PRB(24, phase_moe(F, 0, 2));
        PRB(25, phase_moe(F, 0, 4));
    }
#endif
}

extern "C" void kernel_launch(void* const* d_in, const int* in_sizes, int n_in, void* d_out, int out_size, void* d_ws, size_t ws_size, hipStream_t stream) {
    if (n_in != 28 || out_size != T * DM || ws_size < WS_END2) { fprintf(stderr, "kernel_launch: unexpected shapes (n_in %d out %d ws %zu)\n", n_in, out_size, ws_size); return; }
    static int grid = 0;
    if (grid == 0) {
        int dev = 0, cus = 0;
        if (hipGetDevice(&dev) != hipSuccess || hipDeviceGetAttribute(&cus, hipDeviceAttributeMultiprocessorCount, dev) != hipSuccess) { fprintf(stderr, "kernel_launch: device query failed\n"); grid = -1; return; }
        if (hipFuncSetAttribute((const void*)mk, hipFuncAttributeMaxDynamicSharedMemorySize, LDS_BYTES) != hipSuccess) { fprintf(stderr, "kernel_launch: hipFuncSetAttribute failed\n"); grid = -1; return; }
        if (cus < 256) { fprintf(stderr, "kernel_launch: %d CUs; this kernel is built for a 256-CU device\n", cus); grid = -1; return; }
        grid = 256;
    }
    if (grid < 0) return;
    Args a{};
    for (int i = 0; i < 28; ++i) a.p.in[i] = (const float*)d_in[i];
    a.p.out = (float*)d_out; a.p.ws = (unsigned char*)d_ws;
    const P& p = a.p;
    if (hipMemsetAsync((char*)d_ws + WS_CTL, 0, CTL_ZERO_BYTES, stream) != hipSuccess) { fprintf(stderr, "kernel_launch: hipMemsetAsync failed\n"); return; }
    a.ph_lo = 0; a.ph_hi = N_PHASES;
    void* kargs[] = {&a};
    hipError_t e = hipLaunchCooperativeKernel((const void*)mk, dim3(grid), dim3(NTHR), kargs, LDS_BYTES, stream);
    if (e != hipSuccess) fprintf(stderr, "kernel_launch: cooperative launch failed: %s (grid %d)\n", hipGetErrorString(e), grid);
}
```

```cpp
#include <hip/hip_runtime.h>
#include <cstdio>
#include <cstdint>

constexpr int DM = 1024, NB = 8, SEQ = 4096, DEPTH = 2, T = NB * SEQ;
constexpr int HD = 64, INC = 1536, CW = 512, NG = 32, GC = 16, NS = 64;
constexpr int NEXP = 16, DEXP = 256;
constexpr float EPS = 1e-6f;
constexpr float LOG2E = 1.4426950408889634f;
constexpr float QSCALE = 0.125f * LOG2E;
constexpr int CH = 32, NCH = SEQ / CH;
constexpr int UXP = 768;

typedef unsigned short bf16;
typedef float f32x2_cv __attribute__((ext_vector_type(2))); typedef __bf16 bf16x2_cv __attribute__((ext_vector_type(2)));
__device__ __forceinline__ unsigned pk2(float lo, float hi) { const f32x2_cv v = {lo, hi}; return __builtin_bit_cast(unsigned, __builtin_convertvector(v, bf16x2_cv)); }
__device__ __forceinline__ unsigned f2bf(float f) { return pk2(f, 0.f) & 0xffffu; }
__device__ __forceinline__ float bf2f(unsigned h) { return __builtin_bit_cast(float, h << 16); }
__device__ __forceinline__ float bfr(float f) { return bf2f(f2bf(f)); }

constexpr size_t MiB = 1u << 20;
constexpr size_t WS_CTL = 0;
constexpr size_t WS_SSQX = 1 * MiB;
constexpr size_t WS_SSQA = 3 * MiB;
constexpr size_t WS_SSQB = 4 * MiB;
constexpr size_t WS_SSQC = 5 * MiB;
constexpr size_t WS_XB = 8 * MiB;
constexpr size_t WS_QA = 72 * MiB;
constexpr size_t WS_KA = 88 * MiB;
constexpr size_t WS_VA = 96 * MiB;
constexpr size_t WS_QB = 104 * MiB;
constexpr size_t WS_KB = 120 * MiB;
constexpr size_t WS_VB = 128 * MiB;
constexpr size_t WS_UX = 136 * MiB;
constexpr size_t WS_XEND = 184 * MiB;
constexpr size_t WS_YC = 216 * MiB;
constexpr size_t WS_MIX = 248 * MiB;
constexpr size_t WS_YTMP = 312 * MiB;
constexpr size_t WS_END = 376 * MiB;

struct P {
    const float* in[28];
    float* out;
    unsigned char* ws;
};

template <int CTRL> __device__ __forceinline__ float dpp_add(float v) { return v + __builtin_bit_cast(float, __builtin_amdgcn_update_dpp(0, __builtin_bit_cast(int, v), CTRL, 0xf, 0xf, true)); }
__device__ __forceinline__ float sum8(float v) { v = dpp_add<0xB1>(v); v = dpp_add<0x4E>(v); return dpp_add<0x141>(v); }
__device__ __forceinline__ float wave_sum(float v) {
    v = dpp_add<0x140>(sum8(v));
    const int b = __builtin_bit_cast(int, v);
    return (__builtin_bit_cast(float, __builtin_amdgcn_readlane(b, 0)) + __builtin_bit_cast(float, __builtin_amdgcn_readlane(b, 16))) + (__builtin_bit_cast(float, __builtin_amdgcn_readlane(b, 32)) + __builtin_bit_cast(float, __builtin_amdgcn_readlane(b, 48)));
}
__device__ __forceinline__ float sum_xor16(float v) { auto r = __builtin_amdgcn_permlane16_swap(__float_as_uint(v), __float_as_uint(v), false, false); return __uint_as_float(r[0]) + __uint_as_float(r[1]); }
__device__ __forceinline__ float sum_xor32(float v) { auto r = __builtin_amdgcn_permlane32_swap(__float_as_uint(v), __float_as_uint(v), false, false); return __uint_as_float(r[0]) + __uint_as_float(r[1]); }
__device__ __forceinline__ float other_xor32(float v, bool upper) { auto r = __builtin_amdgcn_permlane32_swap(__float_as_uint(v), __float_as_uint(v), false, false); return __uint_as_float(upper ? r[0] : r[1]); }
__device__ __forceinline__ float block_sum256(float v, float* red) {
    v = wave_sum(v);
    __syncthreads();
    if ((threadIdx.x & 63) == 0) red[threadIdx.x >> 6] = v;
    __syncthreads();
    return red[0] + red[1] + red[2] + red[3];
}


typedef unsigned u32x4_wt __attribute__((ext_vector_type(4)));
__device__ __forceinline__ void st16_wt(void* p, u32x4_wt v) { asm volatile("global_store_dwordx4 %0, %1, off sc1\n\ts_nop 1" :: "v"(p), "v"(v) : "memory"); }

#define LAS __attribute__((address_space(3)))
#define GAS __attribute__((address_space(1)))
typedef short bf16x8 __attribute__((ext_vector_type(8)));
typedef float f32x4 __attribute__((ext_vector_type(4)));
typedef float f32x2 __attribute__((ext_vector_type(2)));
typedef unsigned u32x4 __attribute__((ext_vector_type(4)));
typedef unsigned u32x2 __attribute__((ext_vector_type(2)));
constexpr int NWAVES = 8, NTHR = 512;
constexpr int RING_BYTES = 131072, LDS_BYTES = 160 * 1024, LDS_MISC = LDS_BYTES - 256;
constexpr int LDS_EPI = RING_BYTES, LDS_EPI_WAVE = 1536;
constexpr int LDS_ROPE = LDS_EPI + 8 * LDS_EPI_WAVE;

constexpr size_t WS_W = 376 * MiB;
constexpr size_t WL_WIN = 0;
constexpr size_t WL_WOUT = 3 * MiB;
constexpr size_t WL_WGLU = 5 * MiB;
constexpr size_t WL_WR = 5 * MiB + 512 * 1024;
constexpr size_t WL_A32 = 5 * MiB + 768 * 1024;
constexpr size_t WL_WGU = 6 * MiB;
constexpr size_t WL_WDN = 22 * MiB;
constexpr size_t WL_S5B2 = 30 * MiB;
constexpr size_t WL_S5B1 = 54 * MiB;
constexpr size_t WL_SIZE = 62 * MiB;
constexpr size_t WS_ROPE = WS_W + 2 * WL_SIZE;
constexpr size_t WS_END2 = WS_ROPE + 1 * MiB;


namespace g8 {
constexpr int BM = 256, BK = 64, HALF = 128, HTB = HALF * BK * 2, STAGE_BYTES = 8 * HTB, NXCD = 8, WGM = 8;
__device__ __forceinline__ int lds_byte(int r, int c) { const int st = (r >> 4) * 2 + (c >> 5), rr = r & 15, cc = c & 31, ob = rr * 64 + cc * 2; return st * 1024 + (ob ^ (((ob >> 9) & 1) << 5)); }
__device__ __forceinline__ void stage_rc(int b, int& R, int& C) { const int st = b / 1024, sb = b % 1024, swz = sb ^ (((sb >> 9) & 1) << 5); R = (st >> 1) * 16 + swz / 64; C = (st & 1) * 32 + (swz % 64) / 2; }
__device__ __forceinline__ int perm32(int rho) { const int n = rho >> 4, i = rho & 15; return 8 * (i >> 2) + 4 * n + (i & 3); }

struct Unit {
    unsigned A, B;
    unsigned lda, ldb;
    int nt;
    int fin;
    const int* rows;
    int nv;
    int pm, pn, a0, r0;
    int kind, dep;
    unsigned B2;
};
__device__ __forceinline__ bool tile_order(int L, int nM, int nN, int& pm, int& pn) {
    const int nwg = nM * nN; if (L >= nwg) return false;
    int wgid = L; { const int q = nwg / NXCD, r = nwg % NXCD, xcd = wgid % NXCD, off = wgid / NXCD; wgid = (xcd < r ? xcd * (q + 1) : r * (q + 1) + (xcd - r) * q) + off; }
    const int nig = WGM * nN, gid = wgid / nig, fm = gid * WGM, gsz = (nM - fm) < WGM ? (nM - fm) : WGM;
    pm = fm + ((wgid % nig) % gsz); pn = (wgid % nig) / gsz; return true;
}


__device__ __forceinline__ void unit_ready(const Unit& u, unsigned char* wsbase, int wid) {
    if (u.dep < 0) return;
    if (wid == 0) {
        unsigned* w = (unsigned*)wsbase + u.dep; unsigned spins = 0;
        while ((unsigned)__builtin_amdgcn_readfirstlane(__hip_atomic_load(w, __ATOMIC_RELAXED, __HIP_MEMORY_SCOPE_AGENT)) < 32u) { __builtin_amdgcn_s_sleep(2); if (++spins > (1u << 17)) break; }
        __builtin_amdgcn_fence(__ATOMIC_ACQUIRE, "agent");
        asm volatile("s_waitcnt vmcnt(0)" ::: "memory");
    }
    asm volatile("" ::: "memory"); __builtin_amdgcn_s_barrier(); asm volatile("" ::: "memory");
}

template <class Epi, class Sched>
__device__ __forceinline__ void gemm_phase(LAS unsigned char* lds, const int tid, unsigned char* wsbase, const Sched& S, const Epi& E) {
    const __amdgpu_buffer_rsrc_t rsrc = __builtin_amdgcn_make_buffer_rsrc((void*)wsbase, 0, 0x7fffffff, 0x00020000);
    const int wid = __builtin_amdgcn_readfirstlane(tid >> 6), lane = tid & 63, wr = wid >> 2, wc = wid & 3, fr = lane & 15, fq = lane >> 4;
    int R0, C0, R1, C1; stage_rc(tid * 16, R0, C0); stage_rc(tid * 16 + 8192, R1, C1);
    const int Rb0 = (R0 & ~31) + perm32(R0 & 31), Rb1 = (R1 & ~31) + perm32(R1 & 31);
    const unsigned ldsw = (unsigned)wid * 1024u;
    const int aoff = lds_byte(wr * 64 + fr, fq * 8), boff = lds_byte(wc * 32 + fr, fq * 8);
#define G8_SA(b, h) (((b) * 2 + (h)) * HTB)
#define G8_SB(b, h) ((4 + (b) * 2 + (h)) * HTB)
#define G8_STG(bufoff, gbase, o0, o1) do { \
        __builtin_amdgcn_raw_ptr_buffer_load_lds(rsrc, (LAS unsigned*)(lds + (bufoff) + ldsw), 16, (o0), (gbase), 0, 0); \
        __builtin_amdgcn_raw_ptr_buffer_load_lds(rsrc, (LAS unsigned*)(lds + (bufoff) + ldsw + 8192), 16, (o1), (gbase), 0, 0); } while (0)
#define G8_LDA(dst, b, h) do { _Pragma("unroll") for (int m = 0; m < 4; ++m) _Pragma("unroll") for (int k = 0; k < 2; ++k) dst[m][k] = *(const LAS bf16x8*)(lds + G8_SA(b, h) + aoff + m * 2048 + k * 1024); } while (0)
#define G8_LDB(dst, b, h) do { _Pragma("unroll") for (int n = 0; n < 2; ++n) _Pragma("unroll") for (int k = 0; k < 2; ++k) dst[n][k] = *(const LAS bf16x8*)(lds + G8_SB(b, h) + boff + n * 2048 + k * 1024); } while (0)
#define G8_MMA(ai, bj, At, Bt) do { __builtin_amdgcn_s_setprio(1); _Pragma("unroll") for (int m = 0; m < 4; ++m) _Pragma("unroll") for (int n = 0; n < 2; ++n) _Pragma("unroll") for (int k = 0; k < 2; ++k) \
        acc[ai][bj][m][n] = __builtin_amdgcn_mfma_f32_16x16x32_bf16(Bt[n][k], At[m][k], acc[ai][bj][m][n], 0, 0, 0); __builtin_amdgcn_s_setprio(0); } while (0)
#define G8_WAIT_V(n) asm volatile("s_waitcnt vmcnt(" #n ")" ::: "memory")
#define G8_WAIT_L(n) asm volatile("s_waitcnt lgkmcnt(" #n ")" ::: "memory")
#define G8_BAR __builtin_amdgcn_s_barrier()
#define G8_SCHED __builtin_amdgcn_sched_barrier(0)
#define G8_OFFS(u, a00, a01, a10, a11, b0, b1) do { \
        int i00 = R0, i01 = R1, i10 = 128 + R0, i11 = 128 + R1; \
        if ((u).rows) { i00 = R0 < (u).nv ? (u).rows[R0] : 0; i01 = R1 < (u).nv ? (u).rows[R1] : 0; i10 = 128 + R0 < (u).nv ? (u).rows[128 + R0] : 0; i11 = 128 + R1 < (u).nv ? (u).rows[128 + R1] : 0; } \
        a00 = (unsigned)i00 * (u).lda + (unsigned)C0 * 2u; a01 = (unsigned)i01 * (u).lda + (unsigned)C1 * 2u; \
        a10 = (unsigned)i10 * (u).lda + (unsigned)C0 * 2u; a11 = (unsigned)i11 * (u).lda + (unsigned)C1 * 2u; \
        b0 = (unsigned)Rb0 * (u).ldb + (unsigned)C0 * 2u; b1 = (unsigned)Rb1 * (u).ldb + (unsigned)C1 * 2u; } while (0)
    Unit cur, nxt; int ui = 0;
    if (!S.next(0, cur)) return;
    unit_ready(cur, wsbase, wid);
    unsigned vA00, vA01, vA10, vA11, vB0, vB1, nA00, nA01, nA10, nA11, nB0, nB1;
    G8_OFFS(cur, vA00, vA01, vA10, vA11, vB0, vB1);
    f32x4 acc[2][2][4][2];
#pragma unroll
    for (int a = 0; a < 2; ++a)
#pragma unroll
        for (int b = 0; b < 2; ++b)
#pragma unroll
            for (int m = 0; m < 4; ++m)
#pragma unroll
                for (int n = 0; n < 2; ++n) acc[a][b][m][n] = (f32x4){0.f, 0.f, 0.f, 0.f};
    bf16x8 At[4][2], B0[2][2], B1[2][2];
    unsigned cA = cur.A, cB = cur.B, hsB = (unsigned)HALF * cur.ldb;
    G8_STG(G8_SB(0, 0), cB, vB0, vB1); G8_STG(G8_SB(0, 1), cB + hsB, vB0, vB1); G8_STG(G8_SA(0, 0), cA, vA00, vA01); G8_STG(G8_SA(0, 1), cA, vA10, vA11);
    if (wr == 1) G8_BAR;
    G8_WAIT_V(2); G8_BAR;
    G8_STG(G8_SB(1, 0), cB + 128, vB0, vB1); G8_STG(G8_SA(1, 0), cA + 128, vA00, vA01); G8_STG(G8_SB(1, 1), cB + hsB + 128, vB0, vB1);
    G8_WAIT_V(6); G8_BAR;
    for (;;) {
        const bool has_next = S.next(ui + 1, nxt);
        unsigned nA = cA, nB = cB, nhsB = hsB;
        nA00 = vA00; nA01 = vA01; nA10 = vA10; nA11 = vA11; nB0 = vB0; nB1 = vB1;
        const bool nx_g = has_next && nxt.rows != nullptr;
        if (has_next) { nA = nxt.A; nB = nxt.B; nhsB = (unsigned)HALF * nxt.ldb;
            if (nx_g) {
                nB0 = (unsigned)Rb0 * nxt.ldb + (unsigned)C0 * 2u; nB1 = (unsigned)Rb1 * nxt.ldb + (unsigned)C1 * 2u;
                const unsigned ro_ = (unsigned)((const unsigned char*)nxt.rows - (const unsigned char*)wsbase);
#pragma unroll
                for (int q_ = 0; q_ < 4; ++q_) __builtin_amdgcn_raw_ptr_buffer_load_lds(rsrc, (LAS unsigned*)(lds + LDS_EPI + wid * LDS_EPI_WAVE + q_ * 256), 4, (unsigned)lane * 4u, ro_ + (unsigned)q_ * 256u, 0, 0); }
            else { G8_OFFS(nxt, nA00, nA01, nA10, nA11, nB0, nB1); } }
        const int nt = cur.nt;
        for (int t = 0; t < nt; t += 2) {
            const bool last = (t == nt - 2);
            if (last && has_next) unit_ready(nxt, wsbase, wid);
            if (last && nx_g) { const LAS int* rl_ = (const LAS int*)(lds + LDS_EPI + wid * LDS_EPI_WAVE);
                const int nv_ = nxt.nv; const int i00 = R0 < nv_ ? rl_[R0] : 0, i01 = R1 < nv_ ? rl_[R1] : 0, i10 = 128 + R0 < nv_ ? rl_[128 + R0] : 0, i11 = 128 + R1 < nv_ ? rl_[128 + R1] : 0;
                nA00 = (unsigned)i00 * nxt.lda + (unsigned)C0 * 2u; nA01 = (unsigned)i01 * nxt.lda + (unsigned)C1 * 2u; nA10 = (unsigned)i10 * nxt.lda + (unsigned)C0 * 2u; nA11 = (unsigned)i11 * nxt.lda + (unsigned)C1 * 2u; }
            const unsigned a1 = cA + (unsigned)(t + 1) * 128u;
            const unsigned a2 = last ? nA : cA + (unsigned)(t + 2) * 128u, b2 = last ? nB : ((cur.B2 == 0u || t + 2 < (nt >> 1)) ? cB + (unsigned)(t + 2) * 128u : cur.B2 + (unsigned)(t + 2 - (nt >> 1)) * 128u);
            const unsigned hs2 = last ? nhsB : hsB;
            const unsigned oA00 = last ? nA00 : vA00, oA01 = last ? nA01 : vA01, oA10 = last ? nA10 : vA10, oA11 = last ? nA11 : vA11, oB0 = last ? nB0 : vB0, oB1 = last ? nB1 : vB1;
            const unsigned a3 = a2 + 128u, b3 = b2 + 128u;
            G8_LDB(B0, 0, 0); G8_LDB(B1, 0, 1); G8_SCHED; G8_LDA(At, 0, 0); G8_STG(G8_SA(1, 1), a1, vA10, vA11);
            G8_WAIT_V(8); G8_WAIT_L(0); G8_BAR; G8_MMA(0, 0, At, B0); G8_MMA(0, 1, At, B1); G8_BAR; G8_SCHED;
            G8_LDA(At, 0, 1); G8_STG(G8_SB(0, 0), b2, oB0, oB1); G8_STG(G8_SB(0, 1), b2 + hs2, oB0, oB1); G8_STG(G8_SA(0, 0), a2, oA00, oA01);
            G8_WAIT_V(8); G8_WAIT_L(0); G8_BAR; G8_MMA(1, 0, At, B0); G8_MMA(1, 1, At, B1); G8_BAR; G8_SCHED;
            G8_LDB(B0, 1, 0); G8_LDB(B1, 1, 1); G8_SCHED; G8_LDA(At, 1, 0); G8_STG(G8_SA(0, 1), a2, oA10, oA11);
            G8_WAIT_V(8); G8_WAIT_L(0); G8_BAR; G8_MMA(0, 0, At, B0); G8_MMA(0, 1, At, B1); G8_BAR; G8_SCHED;
            G8_LDA(At, 1, 1); G8_STG(G8_SB(1, 0), b3, oB0, oB1); G8_STG(G8_SB(1, 1), b3 + hs2, oB0, oB1); G8_STG(G8_SA(1, 0), a3, oA00, oA01);
            G8_WAIT_V(8); G8_WAIT_L(0); G8_BAR; G8_MMA(1, 0, At, B0); G8_MMA(1, 1, At, B1); G8_BAR; G8_SCHED;
        }
        if (wr == 0) G8_BAR;
        { int fr_ = fr, fq_ = fq; asm volatile("" : "+v"(fr_), "+v"(fq_));
          E(acc, cur, wr, wc, fr_, fq_, lds + LDS_EPI + wid * LDS_EPI_WAVE); }
        if (!has_next) break;
        if (cur.fin) {
#pragma unroll
            for (int a = 0; a < 2; ++a)
#pragma unroll
                for (int b = 0; b < 2; ++b)
#pragma unroll
                    for (int m = 0; m < 4; ++m)
#pragma unroll
                        for (int n = 0; n < 2; ++n) acc[a][b][m][n] = (f32x4){0.f, 0.f, 0.f, 0.f};
        }
        cur = nxt; cA = nA; cB = nB; hsB = nhsB; vA00 = nA00; vA01 = nA01; vA10 = nA10; vA11 = nA11; vB0 = nB0; vB1 = nB1; ++ui;
        if (wr == 1) G8_BAR;
    }
    G8_WAIT_V(0);
    G8_BAR;
#undef G8_SA
#undef G8_SB
#undef G8_STG
#undef G8_LDA
#undef G8_LDB
#undef G8_MMA
#undef G8_WAIT_V
#undef G8_WAIT_L
#undef G8_BAR
#undef G8_SCHED
#undef G8_OFFS
}
}

struct Frame {
    LAS unsigned char* lds; char* ldsg;
    const LAS P* pl;
    unsigned char* ws; float* out;
    int tid, lane, wave, vcu, G;
};
__device__ __forceinline__ const void* uniptr(const void* q) { const unsigned long long v = (unsigned long long)q; const unsigned lo = __builtin_amdgcn_readfirstlane((unsigned)v), hi = __builtin_amdgcn_readfirstlane((unsigned)(v >> 32)); return (const void*)(((unsigned long long)hi << 32) | lo); }
#define PINP(i) ((const float*)uniptr(F.pl->in[i]))
constexpr size_t WL_QKG = 5 * MiB + 800 * 1024;
constexpr size_t WL_SINK = WL_QKG + 1024;
constexpr size_t WL_GLUB = WL_QKG + 2048;
constexpr size_t WL_RB = WL_QKG + 4096 + 2048;

__device__ __forceinline__ void s5_prep(Frame& F, int l, int g, int qtr) {
    LAS f32x2* apw = (LAS f32x2*)(F.lds);
    LAS f32x2* bb = (LAS f32x2*)(F.lds + 33792);
    LAS f32x2* cc = (LAS f32x2*)(F.lds + 33792 + 16384);
    LAS float* kt = (LAS float*)(F.lds + 33792 + 32768);
    const int tid = F.tid, lane = F.lane;
    unsigned char* wl = F.ws + WS_W + (size_t)l * WL_SIZE;
    __syncthreads();
    f32x2 cv[4];
#pragma unroll
    for (int k = 0; k < 4; ++k) { const int i = tid + k * NTHR, dir = i >> 10, ho = (i >> 6) & 15, s = i & 63; const size_t pb = (((size_t)l * 2 + dir) * NG + g);
        cv[k] = (f32x2){PINP(13)[(pb * GC + ho) * NS + s], PINP(14)[(pb * GC + ho) * NS + s]}; }
    const float* dsk = PINP(15) + ((size_t)l * NG + g) * GC;
    const float dsk0 = dsk[(tid >> 6) & 15], dsk1 = dsk[((tid >> 6) & 15) + 8];
    if (tid < 128) {
        const int dir = tid >> 6, s = tid & 63;
        const size_t pb = (((size_t)l * 2 + dir) * NG + g);
        const f32x4* brp = (const f32x4*)(PINP(11) + (pb * NS + s) * GC); const f32x4* bip = (const f32x4*)(PINP(12) + (pb * NS + s) * GC);
        f32x4 brv[4], biv[4];
#pragma unroll
        for (int q = 0; q < 4; ++q) { brv[q] = brp[q]; biv[q] = bip[q]; }
        const float ldt = PINP(10)[pb], lr0 = PINP(8)[pb * NS + s], li = PINP(9)[pb * NS + s];
        const float dt = expf(ldt);
        const float lr = fminf(lr0, -1e-4f);
        const float mag = expf(lr * dt), ph = li * dt;
        const float ar = mag * cosf(ph), ai = mag * sinf(ph);
        const float den = lr * lr + li * li, nr = ar - 1.f, ni = ai;
        const float cr = (nr * lr + ni * li) / den, ci = (ni * lr - nr * li) / den;
        double xr = 1.0, xi = 0.0;
        for (int t = 0; t <= 32; ++t) { apw[(dir * 64 + s) * 33 + t] = (f32x2){(float)xr, (float)xi}; const double nxr = xr * ar - xi * ai, nxi = xr * ai + xi * ar; xr = nxr; xi = nxi; }
#pragma unroll
        for (int hi = 0; hi < GC; ++hi) { const float br = brv[hi >> 2][hi & 3], bi = biv[hi >> 2][hi & 3]; bb[(dir * 64 + s) * 16 + hi] = (f32x2){cr * br - ci * bi, cr * bi + ci * br}; }
    }
#pragma unroll
    for (int k = 0; k < 4; ++k) cc[tid + k * NTHR] = cv[k];
    __syncthreads();
    if (qtr == 0 && tid < 128) { const int dir = tid >> 6, s = tid & 63; ((f32x2*)(wl + WL_A32))[(dir * NG + g) * 64 + s] = apw[(dir * 64 + s) * 33 + 32]; }
    {   const int dir = F.wave >> 2, ho = lane & 15, kq = lane >> 4, hi = lane & 15;
        float ar_[32]; f32x2 bq[16];
#pragma unroll
        for (int j = 0; j < 16; ++j) { const f32x2 c = cc[(dir * 16 + ho) * 64 + 4 * j + kq]; ar_[j] = c.x; ar_[16 + j] = -c.y; bq[j] = bb[(dir * 64 + 4 * j + kq) * 16 + hi]; }
        for (int tt = 0; tt < 8; ++tt) { const int tau = (F.wave & 3) * 8 + tt; f32x4 acc = (f32x4){0.f, 0.f, 0.f, 0.f}, acc2 = acc;
#pragma unroll
            for (int j = 0; j < 16; ++j) { const f32x2 w = apw[(dir * 64 + 4 * j + kq) * 33 + tau];
                const float zr = w.x * bq[j].x - w.y * bq[j].y, zi = w.x * bq[j].y + w.y * bq[j].x;
                acc = __builtin_amdgcn_mfma_f32_16x16x4f32(ar_[j], zr, acc, 0, 0, 0); acc2 = __builtin_amdgcn_mfma_f32_16x16x4f32(ar_[16 + j], zi, acc2, 0, 0, 0); }
#pragma unroll
            for (int r = 0; r < 4; ++r) kt[((dir * 32 + tau) * 16 + 4 * kq + r) * 16 + hi] = acc[r] + acc2[r]; }
    }
    __syncthreads();
    bf16* B2 = (bf16*)(wl + WL_S5B2) + (size_t)g * 512 * 768;
    for (int v = tid; v < 128 * 64; v += NTHR) {
        const int n = qtr * 128 + (v >> 6), kv = v & 63, t = n >> 4, ho = n & 15; float o[8];
        {   const int s = kv >> 1, h0 = (kv & 1) * 8;
            f32x4 a0 = (f32x4){0.f, 0.f, 0.f, 0.f}, a1 = a0;
            if (s <= t) { const LAS f32x4* q = (const LAS f32x4*)(kt + ((0 * 32 + (t - s)) * 16 + ho) * 16 + h0); a0 = q[0]; a1 = q[1]; }
            if (s >= t) { const LAS f32x4* q = (const LAS f32x4*)(kt + ((1 * 32 + (s - t)) * 16 + ho) * 16 + h0); a0 = a0 + q[0]; a1 = a1 + q[1]; }
            o[0] = a0.x; o[1] = a0.y; o[2] = a0.z; o[3] = a0.w; o[4] = a1.x; o[5] = a1.y; o[6] = a1.z; o[7] = a1.w;
            if (s == t && (ho >> 3) == (h0 >> 3)) { const float d = (ho & 8) ? dsk1 : dsk0;
#pragma unroll
                for (int e = 0; e < 8; ++e) o[e] += (e == (ho & 7)) ? d : 0.f; }
        }
        u32x4 w4; w4.x = pk2(o[0], o[1]); w4.y = pk2(o[2], o[3]); w4.z = pk2(o[4], o[5]); w4.w = pk2(o[6], o[7]);
        *(u32x4*)(B2 + (size_t)n * 768 + kv * 8) = w4;
    }
    for (int v = tid; v < 128 * 32; v += NTHR) {
        const int n = qtr * 128 + (v >> 5), kv = 64 + (v & 31), t = n >> 4, ho = n & 15; float o[8];
        {   const int j0 = (kv - 64) * 8, q = j0 >> 6, dir = q >> 1, im = q & 1, pw = dir == 0 ? (t + 1) : (32 - t);
#pragma unroll
            for (int e = 0; e < 8; ++e) { const int s = (j0 & 63) + e; const f32x2 c = cc[(dir * 16 + ho) * 64 + s], w = apw[(dir * 64 + s) * 33 + pw];
                o[e] = im ? -(c.x * w.y + c.y * w.x) : (c.x * w.x - c.y * w.y); }
        }
        u32x4 w4; w4.x = pk2(o[0], o[1]); w4.y = pk2(o[2], o[3]); w4.z = pk2(o[4], o[5]); w4.w = pk2(o[6], o[7]);
        *(u32x4*)(B2 + (size_t)n * 768 + kv * 8) = w4;
    }
    bf16* B1 = (bf16*)(wl + WL_S5B1) + (size_t)g * 256 * 512;
    for (int v = tid; v < 64 * 64; v += NTHR) {
        const int j = qtr * 64 + (v >> 6), kv = v & 63, s = kv >> 1, h0 = (kv & 1) * 8, q = j >> 6, dir = q >> 1, im = q & 1, st = j & 63, pw = dir == 0 ? (31 - s) : s;
        const f32x2 w = apw[(dir * 64 + st) * 33 + pw]; float o[8];
#pragma unroll
        for (int e = 0; e < 8; ++e) { const f32x2 b = bb[(dir * 64 + st) * 16 + h0 + e]; o[e] = im ? (w.x * b.y + w.y * b.x) : (w.x * b.x - w.y * b.y); }
        u32x4 w4; w4.x = pk2(o[0], o[1]); w4.y = pk2(o[2], o[3]); w4.z = pk2(o[4], o[5]); w4.w = pk2(o[6], o[7]);
        *(u32x4*)(B1 + (size_t)j * 512 + kv * 8) = w4;
    }
    __syncthreads();
}
struct TJob { const float* src; const float* sc; bf16* dst; int ld, dpitch; };
constexpr int I_IN = 16 * 48, I_OUT = 16 * 32, I_GLU = 8 * 16, I_GU = 16 * 256, I_DN = 16 * 128, I_L = I_IN + I_OUT + I_GLU + I_GU + I_DN;
__device__ __forceinline__ void tjob_decode(Frame& F, int it, TJob& j) {
    const int l = it / I_L; int r = it % I_L; unsigned char* wl = F.ws + WS_W + (size_t)l * WL_SIZE;
    if (r < I_IN) { const int kb = r / 48, nb = r % 48, P0 = nb * 32, pn = P0 >> 8, pp = P0 & 255, bj = pp >> 7, wc = (pp & 127) >> 5, col0 = 256 * pn + 64 * wc + 32 * bj;
        j.src = PINP(2) + (size_t)l * DM * INC + (size_t)(kb * 64) * INC + col0; j.ld = INC; j.sc = PINP(1) + l * DM + kb * 64; j.dst = (bf16*)(wl + WL_WIN) + (size_t)P0 * DM + kb * 64; j.dpitch = DM; return; } r -= I_IN;
    if (r < I_OUT) { const int kb = r / 32, nb = r % 32;
        j.src = PINP(19) + (size_t)l * DM * DM + (size_t)(kb * 64) * DM + nb * 32; j.ld = DM; j.sc = PINP(18) + l * DM + kb * 64; j.dst = (bf16*)(wl + WL_WOUT) + (size_t)nb * 32 * DM + kb * 64; j.dpitch = DM; return; } r -= I_OUT;
    if (r < I_GLU) { const int kb = r / 16, nb = r % 16;
        j.src = PINP(16) + (size_t)l * CW * CW + (size_t)(kb * 64) * CW + nb * 32; j.ld = CW; j.sc = nullptr; j.dst = (bf16*)(wl + WL_WGLU) + (size_t)nb * 32 * CW + kb * 64; j.dpitch = CW; return; } r -= I_GLU;
    if (r < I_GU) { const int e = r >> 8, q = r & 255, kb = q >> 4, nb = q & 15, P0 = nb * 32, half = P0 >> 8, pp = P0 & 255, isup = pp >> 7, f0 = half * 128 + (pp & 127);
        j.src = PINP(isup ? 26 : 25) + ((size_t)l * NEXP + e) * DM * DEXP + (size_t)(kb * 64) * DEXP + f0; j.ld = DEXP; j.sc = PINP(20) + l * DM + kb * 64; j.dst = (bf16*)(wl + WL_WGU) + ((size_t)e * 512 + P0) * DM + kb * 64; j.dpitch = DM; return; } r -= I_GU;
    { const int e = r >> 7, q = r & 127, kb = q >> 5, nb = q & 31;
        j.src = PINP(27) + ((size_t)l * NEXP + e) * DEXP * DM + (size_t)(kb * 64) * DM + nb * 32; j.ld = DM; j.sc = nullptr; j.dst = (bf16*)(wl + WL_WDN) + ((size_t)e * DM + nb * 32) * DEXP + kb * 64; j.dpitch = DEXP; }
}
#define TLOAD(j, v, f) do { _Pragma("unroll") for (int i = 0; i < 8; ++i) { v[i] = *(const f32x4*)(j.src + (size_t)(8 * i + (lane >> 3)) * j.ld + (lane & 7) * 4); f[i] = j.sc ? j.sc[8 * i + (lane >> 3)] : 1.f; } } while (0)
#define TFIN(j, v, f) do { \
    _Pragma("unroll") for (int i = 0; i < 8; ++i) { const int kk = 8 * i + (lane >> 3); LAS float* d = scr + kk * 33 + (lane & 7) * 4; d[0] = v[i].x * f[i]; d[1] = v[i].y * f[i]; d[2] = v[i].z * f[i]; d[3] = v[i].w * f[i]; } \
    asm volatile("s_waitcnt lgkmcnt(0)" ::: "memory"); \
    _Pragma("unroll") for (int j4 = 0; j4 < 4; ++j4) { const int n = (lane >> 3) + 8 * j4, c = lane & 7; const LAS float* s = scr + (8 * c) * 33 + n; \
        u32x4 o; o.x = pk2(s[0 * 33], s[1 * 33]); o.y = pk2(s[2 * 33], s[3 * 33]); o.z = pk2(s[4 * 33], s[5 * 33]); o.w = pk2(s[6 * 33], s[7 * 33]); \
        *(u32x4*)(j.dst + (size_t)n * j.dpitch + 8 * c) = o; } \
    asm volatile("s_waitcnt lgkmcnt(0)" ::: "memory"); } while (0)
template <int PART> __device__ __forceinline__ void phase_prep(Frame& F) {
    __syncthreads();
    {   const int wg = (int)blockIdx.x - (PART && F.G >= 2 * NG * 4 ? NG * 4 : 0);
        if (wg >= 0) for (int job = wg + PART * NG * 4; job < (PART + 1) * NG * 4; job += F.G) s5_prep(F, job >> 7, (job >> 2) & 31, job & 3); }
    if (PART == 0 && blockIdx.x >= 240 && F.tid < 64) {
        f32x2* rt = (f32x2*)(F.ws + WS_ROPE);
        for (int i = (blockIdx.x - 240) * 64 + F.tid; i < 1024; i += 1024) { const int pos = i >> 4, f = i & 15; const float inv = powf(10000.f, -(float)f / 16.f); const float ang = (float)pos * inv; rt[i] = (f32x2){cosf(ang), sinf(ang)}; }
    }
    if (PART == 0) {
        for (int e = (int)blockIdx.x * NTHR + F.tid; e < DEPTH * 48 * DM; e += F.G * NTHR) {
            const int l = e / (48 * DM), i = e % (48 * DM), rho = i / DM, k = i % DM, q = 8 * (rho >> 4) + ((rho & 15) >> 1), part = rho & 1; unsigned o = 0u;
            if (q < 20) { const float w = PINP(20)[l * DM + k] * (q < 4 ? PINP(21)[((size_t)l * DM + k) * 4 + q] : PINP(23)[((size_t)l * DM + k) * 16 + (q - 4)]); const unsigned hb = f2bf(w); o = part ? f2bf(w - bf2f(hb)) : hb; }
            ((bf16*)(F.ws + WS_W + (size_t)l * WL_SIZE + WL_WR))[i] = (bf16)o; }
    }
    if (PART == 0 && blockIdx.x >= 1 && blockIdx.x <= 2) {
        const int l = blockIdx.x - 1;
        unsigned char* wl = F.ws + WS_W + (size_t)l * WL_SIZE;
        LAS float* qk = (LAS float*)F.lds;
        if (F.tid < 256) { const int which = F.tid >> 6, d = F.tid & 63; const float gv_ = PINP(3 + which)[l * HD + d]; ((float*)(wl + WL_QKG))[F.tid] = gv_; qk[F.tid] = gv_; }
        if (F.tid < 4) ((float*)(wl + WL_SINK))[F.tid] = PINP(7)[l * 4 + F.tid] * LOG2E;
        __syncthreads();
        if (F.tid == 0) { float gq = 0.f, gk = 0.f; for (int d = 0; d < HD; ++d) { gq = fmaxf(gq, fabsf(qk[d])); gk = fmaxf(gk, fabsf(qk[64 + d])); }
            ((float*)(wl + WL_SINK))[8] = fmaxf(0.f, 64.f * QSCALE * 1.02f * gq * gk - 20.f);
            float gqb = 0.f, gkb = 0.f; for (int d = 0; d < HD; ++d) { gqb = fmaxf(gqb, fabsf(qk[128 + d])); gkb = fmaxf(gkb, fabsf(qk[192 + d])); }
            ((float*)(wl + WL_SINK))[9] = fmaxf(0.f, 64.f * QSCALE * 1.02f * gqb * gkb - 20.f); }
        ((float*)(wl + WL_GLUB))[F.tid] = PINP(17)[l * CW + F.tid];
        if (F.tid < 20) ((float*)(wl + WL_RB))[F.tid] = F.tid < 4 ? PINP(22)[l * 4 + F.tid] : PINP(24)[l * 16 + F.tid - 4];
    }
    if (PART == 0 && F.tid == 0) ((unsigned*)F.ws)[7168 + blockIdx.x] = (unsigned)__builtin_amdgcn_s_getreg((3 << 11) | 20) & 0xFu;
    LAS float* scr = (LAS float*)(F.lds + F.wave * 16384);
    __syncthreads();
    const int gw = F.vcu * NWAVES + F.wave, NGW = F.G * NWAVES;
    const bool heavy = F.G == 256 && (PART == 0 ? blockIdx.x < 128 : blockIdx.x >= 128);
    const int cw = (((int)blockIdx.x & 127) * NWAVES + F.wave);
    constexpr int N1 = 2 * I_L - I_IN;
    {
        const int lane = F.lane;
        auto item_of = [&](int k_) -> int {
            int it0;
            if (PART == 0 || F.G != 256) { it0 = gw + k_ * NGW; if (it0 >= (PART == 0 ? I_IN : N1)) return -1; }
            else { if (heavy) { if (k_ >= 6) return -1; it0 = 8192 + cw + 1024 * k_; } else { if (k_ >= 8) return -1; it0 = cw + 1024 * k_; } if (it0 >= N1) return -1; }
            return PART == 0 ? it0 : it0 + I_IN; };
        TJob ja, jb, jc; f32x4 va[8], vb[8], vc[8]; float fa[8], fb[8], fc[8];
        int k_ = 0; int ia = item_of(0), ib = item_of(1), ic = -1;
        if (ia >= 0) { tjob_decode(F, ia, ja); TLOAD(ja, va, fa); }
        if (ib >= 0) { tjob_decode(F, ib, jb); TLOAD(jb, vb, fb); }
        while (ia >= 0) {
            ic = item_of(k_ + 2);
            if (ic >= 0) { tjob_decode(F, ic, jc); TLOAD(jc, vc, fc); }
            TFIN(ja, va, fa);
            if (ib < 0) break;
            ia = item_of(k_ + 3);
            if (ia >= 0) { tjob_decode(F, ia, ja); TLOAD(ja, va, fa); }
            TFIN(jb, vb, fb);
            if (ic < 0) break;
            ib = item_of(k_ + 4);
            if (ib >= 0) { tjob_decode(F, ib, jb); TLOAD(jb, vb, fb); }
            TFIN(jc, vc, fc);
            k_ += 3;
        }
    }
    if (PART != 0) { asm volatile("s_waitcnt lgkmcnt(0)" ::: "memory"); __syncthreads(); return; }
    bf16* XB = (bf16*)(F.ws + WS_XB); float* SS = (float*)(F.ws + WS_SSQX);
    const float* x0 = PINP(0);
    for (int k_ = 0; ; ++k_) {
        int m0;
        if (F.G != 256) { m0 = (gw + k_ * NGW) * 4; if (m0 >= T) break; }
        else { if (heavy) { if (k_ >= 3) break; m0 = (5120 + cw + 1024 * k_) * 4; } else { if (k_ >= 5) break; m0 = (cw + 1024 * k_) * 4; } }
        f32x4 v[4][4];
#pragma unroll
        for (int r = 0; r < 4; ++r) { const f32x4* xr = (const f32x4*)(x0 + (size_t)(m0 + r) * DM) + F.lane;
#pragma unroll
            for (int j = 0; j < 4; ++j) v[r][j] = xr[64 * j]; }
#pragma unroll
        for (int r = 0; r < 4; ++r) { float s = 0.f;
#pragma unroll
            for (int j = 0; j < 4; ++j) s += (v[r][j].x * v[r][j].x + v[r][j].y * v[r][j].y) + (v[r][j].z * v[r][j].z + v[r][j].w * v[r][j].w);
            s = wave_sum(s);
            u32x2* o8 = (u32x2*)(XB + (size_t)(m0 + r) * DM) + F.lane;
#pragma unroll
            for (int j = 0; j < 4; ++j) o8[64 * j] = (u32x2){pk2(v[r][j].x, v[r][j].y), pk2(v[r][j].z, v[r][j].w)};
            if (F.lane < 16) SS[(size_t)(m0 + r) * 16 + F.lane] = F.lane == 0 ? s : 0.f; }
    }
}

struct SchedGrid {
    unsigned A, B; unsigned lda, ldb; unsigned strideA, strideB; int nM, nN, nt, nbatch, G, c;
    __device__ __forceinline__ bool next(int i, g8::Unit& u) const {
        const int L = i * G + c, per = nM * nN; if (L >= per * nbatch) return false;
        const int g = L / per; int pm, pn; g8::tile_order(L % per, nM, nN, pm, pn);
        u.A = A + (unsigned)g * strideA + (unsigned)pm * 256u * lda; u.B = B + (unsigned)g * strideB + (unsigned)pn * 256u * ldb; u.lda = lda; u.ldb = ldb; u.nt = nt; u.fin = 1; u.rows = nullptr; u.nv = 0; u.pm = pm; u.pn = pn; u.a0 = g; u.r0 = 0; u.kind = 0; u.dep = -1; u.B2 = 0; return true;
    }
};
template <bool NOSTORE> struct EpiInProjT {
    unsigned char* ws; int l; const LAS f32x2* rope_lds;
    __device__ __forceinline__ void operator()(f32x4 (&acc)[2][2][4][2], const g8::Unit& u, int wr, int wc, int fr, int fq, LAS unsigned char* es) const {
        const int pn = u.pn;
        const float* ssqx = (const float*)(ws + WS_SSQX); const LAS f32x2* rope = rope_lds;
        LAS float* r1s = (LAS float*)es;
        {   const int ln = fr + 16 * fq;
            f32x4 q0[4], q1[4];
            const f32x4* p0 = (const f32x4*)(ssqx + (size_t)(u.pm * 256 + wr * 64 + ln) * 16); const f32x4* p1 = (const f32x4*)(ssqx + (size_t)(u.pm * 256 + 128 + wr * 64 + ln) * 16);
#pragma unroll
            for (int i = 0; i < 4; ++i) { q0[i] = p0[i]; q1[i] = p1[i]; }
            float a0 = 0.f, a1 = 0.f;
#pragma unroll
            for (int i = 0; i < 4; ++i) { a0 += (q0[i].x + q0[i].y) + (q0[i].z + q0[i].w); a1 += (q1[i].x + q1[i].y) + (q1[i].z + q1[i].w); }
            r1s[ln] = rsqrtf(a0 * (1.f / DM) + EPS); r1s[64 + ln] = rsqrtf(a1 * (1.f / DM) + EPS);
            asm volatile("s_waitcnt lgkmcnt(0)" ::: "memory"); }
        const float* gq = (const float*)(ws + WS_W + (size_t)l * WL_SIZE + WL_QKG);
        bf16* QA = (bf16*)(ws + WS_QA); bf16* KA = (bf16*)(ws + WS_KA); bf16* VA = (bf16*)(ws + WS_VA); bf16* QB = (bf16*)(ws + WS_QB); bf16* KB = (bf16*)(ws + WS_KB); bf16* VB = (bf16*)(ws + WS_VB); bf16* UX = (bf16*)(ws + WS_UX);
        int kind; const float* g = nullptr; bf16* dst = nullptr; int pitch = 0, hcol = 0;
        if (pn == 0) { kind = 0; g = gq; dst = QA; pitch = 256; hcol = wc * 64; }
        else if (pn == 1) { if (wc < 2) { kind = 1; g = gq + 64; dst = KA; pitch = 128; hcol = wc * 64; } else { kind = 4; dst = VA; pitch = 128; hcol = (wc - 2) * 64; } }
        else if (pn == 2) { kind = 2; g = gq + 128; dst = QB; pitch = 256; hcol = wc * 64; }
        else if (pn == 3) { if (wc < 2) { kind = 3; g = gq + 192; dst = KB; pitch = 128; hcol = wc * 64; } else { kind = 4; dst = VB; pitch = 128; hcol = (wc - 2) * 64; } }
        else kind = 5;
        f32x4 gv[2][2];
        if (kind < 4) {
#pragma unroll
            for (int bj = 0; bj < 2; ++bj)
#pragma unroll
                for (int n = 0; n < 2; ++n) gv[bj][n] = *(const f32x4*)(g + 32 * bj + 8 * fq + 4 * n);
        }
#pragma unroll
        for (int ai = 0; ai < 2; ++ai)
#pragma unroll
            for (int m = 0; m < 4; ++m) {
                const int row = u.pm * 256 + ai * 128 + wr * 64 + m * 16 + fr;
                const float r1 = r1s[64 * ai + 16 * m + fr];
                f32x4 v[2][2];
#pragma unroll
                for (int bj = 0; bj < 2; ++bj)
#pragma unroll
                    for (int n = 0; n < 2; ++n) v[bj][n] = acc[ai][bj][m][n] * r1;
                if (kind < 4) {
                    float ss = 0.f;
#pragma unroll
                    for (int bj = 0; bj < 2; ++bj)
#pragma unroll
                        for (int n = 0; n < 2; ++n) ss += (v[bj][n].x * v[bj][n].x + v[bj][n].y * v[bj][n].y) + (v[bj][n].z * v[bj][n].z + v[bj][n].w * v[bj][n].w);
                    ss = sum_xor32(sum_xor16(ss));
                    const float rn = rsqrtf(ss * (1.f / HD) + EPS);
#pragma unroll
                    for (int bj = 0; bj < 2; ++bj)
#pragma unroll
                        for (int n = 0; n < 2; ++n) v[bj][n] = v[bj][n] * rn * gv[bj][n];
                    if (kind < 2) {
                        const int tt = row & (SEQ - 1);
#pragma unroll
                        for (int bj = 0; bj < 2; ++bj) {
                            const int pos = bj == 0 ? (tt >> 6) : (tt & 63);
                            const LAS f32x4* rp = (const LAS f32x4*)(rope + pos * 16 + 8 * (fq & 1));
#pragma unroll
                            for (int n = 0; n < 2; ++n) {
                                const f32x4 cs0 = rp[2 * n], cs1 = rp[2 * n + 1];
                                f32x4 pv; const bool up = fq >= 2;
                                pv.x = other_xor32(v[bj][n].x, up); pv.y = other_xor32(v[bj][n].y, up); pv.z = other_xor32(v[bj][n].z, up); pv.w = other_xor32(v[bj][n].w, up);
                                const f32x4 cc = (f32x4){cs0.x, cs0.z, cs1.x, cs1.z}, sn = (f32x4){cs0.y, cs0.w, cs1.y, cs1.w};
                                v[bj][n] = (fq < 2) ? (v[bj][n] * cc - pv * sn) : (pv * sn + v[bj][n] * cc);
                            }
                        }
                    }
                    if (kind == 0 || kind == 2) {
#pragma unroll
                        for (int bj = 0; bj < 2; ++bj)
#pragma unroll
                            for (int n = 0; n < 2; ++n) v[bj][n] = v[bj][n] * QSCALE;
                    }
                }
                if (kind < 5) {
#pragma unroll
                    for (int bj = 0; bj < 2; ++bj) {
                        u32x4 w; w.x = pk2(v[bj][0].x, v[bj][0].y); w.y = pk2(v[bj][0].z, v[bj][0].w); w.z = pk2(v[bj][1].x, v[bj][1].y); w.w = pk2(v[bj][1].z, v[bj][1].w);
                        if (NOSTORE) asm volatile("" :: "v"(w)); else *(u32x4*)(dst + (size_t)row * pitch + hcol + 32 * bj + 8 * fq) = w;
                    }
                } else {
                    const int b = row >> 12, tt = row & (SEQ - 1), c = tt >> 5, s = tt & 31;
#pragma unroll
                    for (int bj = 0; bj < 2; ++bj) {
                        const int col = 256 * (pn - 4) + 64 * wc + 32 * bj + 8 * fq, g_ = col >> 4, h0 = col & 15;
                        u32x4 w; w.x = pk2(v[bj][0].x, v[bj][0].y); w.y = pk2(v[bj][0].z, v[bj][0].w); w.z = pk2(v[bj][1].x, v[bj][1].y); w.w = pk2(v[bj][1].z, v[bj][1].w);
                        if (NOSTORE) asm volatile("" :: "v"(w)); else *(u32x4*)(UX + ((size_t)g_ * 1024 + b * NCH + c) * UXP + s * GC + h0) = w;
                    }
                }
            }
    }
};
typedef EpiInProjT<false> EpiInProj;
struct SchedInProjX {
    unsigned A, B; int c;
    __device__ __forceinline__ bool next(int i, g8::Unit& u) const {
        if (i >= 3) return false;
        const int x = c & 7, cx = c >> 3, r = i, cntU = (cx + 2 - r) / 3;
        int pm, pn;
        if (cx % 3 == r) { const int j = (r == 0 ? 0 : (r == 1 ? 11 : 22)) + cntU; pm = 16 * ((x & ~1) + (j >> 4)) + (j & 15); pn = 4 + (x & 1); }
        else { const int q = (r == 0 ? 0 : (r == 1 ? 21 : 42)) + (cx - cntU); pm = 16 * x + (q >> 2); pn = q & 3; }
        u.A = A + (unsigned)pm * 256u * (DM * 2u); u.B = B + (unsigned)pn * 256u * (DM * 2u); u.lda = DM * 2; u.ldb = DM * 2; u.nt = DM / 64; u.fin = 1; u.rows = nullptr; u.nv = 0; u.pm = pm; u.pn = pn; u.a0 = 0; u.r0 = 0; u.kind = 0; u.dep = -1; u.B2 = 0; return true;
    }
};
__device__ __forceinline__ void phase_inproj(Frame& F, int l) {
    unsigned char* wl = F.ws + WS_W + (size_t)l * WL_SIZE;
    SchedGrid S{(unsigned)WS_XB, (unsigned)(WS_W + (size_t)l * WL_SIZE + WL_WIN), DM * 2, DM * 2, 0, 0, T / 256, INC / 256, DM / 64, 1, F.G, (int)blockIdx.x};
    {   const f32x4* src = (const f32x4*)(F.ws + WS_ROPE); LAS f32x4* dst = (LAS f32x4*)(F.lds + LDS_ROPE);
        __syncthreads();
        for (int i = F.tid; i < 512; i += NTHR) dst[i] = src[i];
        __syncthreads(); }
    EpiInProj E{F.ws, l, (const LAS f32x2*)(F.lds + LDS_ROPE)};
    if (F.G == 256) { SchedInProjX SX{(unsigned)WS_XB, (unsigned)(WS_W + (size_t)l * WL_SIZE + WL_WIN), (int)blockIdx.x}; g8::gemm_phase(F.lds, F.tid, F.ws, SX, E); }
    else g8::gemm_phase(F.lds, F.tid, F.ws, S, E);
}

#if defined(PROBE_SET)
struct EpiNone { __device__ __forceinline__ void operator()(f32x4 (&acc)[2][2][4][2], const g8::Unit& u, int wr, int wc, int fr, int fq, LAS unsigned char* es) const {
#pragma unroll
        for (int a = 0; a < 2; ++a)
#pragma unroll
            for (int b = 0; b < 2; ++b)
#pragma unroll
                for (int m = 0; m < 4; ++m) asm volatile("" :: "v"(acc[a][b][m][0]), "v"(acc[a][b][m][1])); } };
__device__ __forceinline__ void phase_inproj_noepi(Frame& F, int l) {
    SchedGrid S{(unsigned)WS_XB, (unsigned)(WS_W + (size_t)l * WL_SIZE + WL_WIN), DM * 2, DM * 2, 0, 0, T / 256, INC / 256, DM / 64, 1, F.G, (int)blockIdx.x};
    EpiNone E{};
    g8::gemm_phase(F.lds, F.tid, F.ws, S, E);
}
__device__ __forceinline__ void phase_inproj_nostore(Frame& F, int l) {
    SchedGrid S{(unsigned)WS_XB, (unsigned)(WS_W + (size_t)l * WL_SIZE + WL_WIN), DM * 2, DM * 2, 0, 0, T / 256, INC / 256, DM / 64, 1, F.G, (int)blockIdx.x};
    EpiInProjT<true> E{F.ws, l, (const LAS f32x2*)(F.lds + LDS_ROPE)};
    g8::gemm_phase(F.lds, F.tid, F.ws, S, E);
}
#endif


namespace att {
using bf16x8 = __attribute__((ext_vector_type(8))) short;
using s16x4 = __attribute__((ext_vector_type(4))) short;
using f32x16 = __attribute__((ext_vector_type(16))) float;
using u32x4 = __attribute__((ext_vector_type(4))) unsigned;
constexpr int NW = 8, QBLK = 32, QB = QBLK * NW, KVBLK = 64;
constexpr int QP = 256, KP = 128, OP = 1024;
__device__ __forceinline__ int crow(int r, int hi) { return (r & 3) + 8 * (r >> 2) + 4 * hi; }
#define SBAR() __builtin_amdgcn_sched_barrier(0)
constexpr int NSLOT = 3, SLOTB = 8192;
constexpr int LDS_K = 0, LDS_V = NSLOT * SLOTB, LDS_WS = 2 * NSLOT * SLOTB, LDS_OST = LDS_WS + NW * 64 * 4, LDS_ATT = LDS_OST + NW * 4096;
__device__ __forceinline__ void glds16(const void* gsrc, unsigned lds_dst) { unsigned keep;
    asm volatile("s_mov_b32 %0, m0\n\ts_mov_b32 m0, %2\n\ts_nop 0\n\tglobal_load_lds_dwordx4 %1, off\n\ts_mov_b32 m0, %0" : "=&s"(keep) : "v"(gsrc), "s"(lds_dst) : "memory"); }
__device__ __forceinline__ float max3f(float a, float b, float c) { float r; asm("v_max3_f32 %0, %1, %2, %3" : "=v"(r) : "v"(a), "v"(b), "v"(c)); return r; }
__device__ __forceinline__ float max2f(float a, float b) { float r; asm("v_max_f32_e32 %0, %1, %2" : "=v"(r) : "v"(a), "v"(b)); return r; }
__device__ __forceinline__ float fadd_s(float a, float b) { float r; asm("v_add_f32_e32 %0, %1, %2" : "=v"(r) : "v"(a), "v"(b)); return r; }
__device__ __forceinline__ float fsub_s(float a, float b) { float r; asm("v_sub_f32_e32 %0, %1, %2" : "=v"(r) : "v"(a), "v"(b)); return r; }
typedef float f32x2_t __attribute__((ext_vector_type(2))); typedef __bf16 bf16x2_t __attribute__((ext_vector_type(2)));
__device__ __forceinline__ unsigned cvtpk_s(float lo, float hi) { f32x2_t v = {lo, hi}; bf16x2_t b = __builtin_convertvector(v, bf16x2_t); return __builtin_bit_cast(unsigned, b); }
#define WAIT_BAR(N) asm volatile("s_waitcnt vmcnt(" #N ") lgkmcnt(0)\n\ts_barrier" ::: "memory")
__device__ __forceinline__ void qkt(f32x16& p0, f32x16& p1, const char* Kslot, const bf16x8* qr, const f32x16& negm, int r32, int hi) {
    const char* kb = Kslot + hi * 1024 + r32 * 16;
#pragma unroll
    for (int d0 = 0; d0 < 4; ++d0) {
        const bf16x8 b0 = *reinterpret_cast<const bf16x8*>(kb + d0 * 2048);
        const bf16x8 b1 = *reinterpret_cast<const bf16x8*>(kb + d0 * 2048 + 512);
        if (d0 == 0) { p0 = __builtin_amdgcn_mfma_f32_32x32x16_bf16(b0, qr[0], negm, 0, 0, 0); p1 = __builtin_amdgcn_mfma_f32_32x32x16_bf16(b1, qr[0], negm, 0, 0, 0); }
        else { p0 = __builtin_amdgcn_mfma_f32_32x32x16_bf16(b0, qr[d0], p0, 0, 0, 0); p1 = __builtin_amdgcn_mfma_f32_32x32x16_bf16(b1, qr[d0], p1, 0, 0, 0); } }
}
typedef __attribute__((address_space(3))) const char* lds_cptr;
typedef short v4i16_t __attribute__((ext_vector_type(4)));
__device__ __forceinline__ void kload8(bf16x8* kf, lds_cptr kp) {
    kf[0] = *(const __attribute__((address_space(3))) bf16x8*)(kp);        kf[1] = *(const __attribute__((address_space(3))) bf16x8*)(kp + 512);
    kf[2] = *(const __attribute__((address_space(3))) bf16x8*)(kp + 2048); kf[3] = *(const __attribute__((address_space(3))) bf16x8*)(kp + 2560);
    kf[4] = *(const __attribute__((address_space(3))) bf16x8*)(kp + 4096); kf[5] = *(const __attribute__((address_space(3))) bf16x8*)(kp + 4608);
    kf[6] = *(const __attribute__((address_space(3))) bf16x8*)(kp + 6144); kf[7] = *(const __attribute__((address_space(3))) bf16x8*)(kp + 6656);
}
__device__ __forceinline__ void kload2(bf16x8* kf, lds_cptr kp, int j) { kf[2 * j] = *(const __attribute__((address_space(3))) bf16x8*)(kp + j * 2048); kf[2 * j + 1] = *(const __attribute__((address_space(3))) bf16x8*)(kp + j * 2048 + 512); }
__device__ __forceinline__ s16x4 vtr(lds_cptr p) { return __builtin_bit_cast(s16x4, __builtin_amdgcn_ds_read_tr16_b64_v4i16((__attribute__((address_space(3))) v4i16_t*)p)); }
__device__ __forceinline__ float rowmax(const f32x16& p0, const f32x16& p1) {
    float a = max3f(p0[0], p0[1], p1[0]), b = max3f(p0[2], p0[3], p1[1]); a = max3f(a, p1[2], p1[3]);
#pragma unroll
    for (int r = 4; r < 16; r += 4) { a = max3f(a, p0[r], p0[r + 1]); b = max3f(b, p0[r + 2], p0[r + 3]); a = max3f(a, p1[r], p1[r + 1]); b = max3f(b, p1[r + 2], p1[r + 3]); }
    const float m = max2f(a, b);
    auto rr = __builtin_amdgcn_permlane32_swap(__float_as_uint(m), __float_as_uint(m), false, false);
    return max2f(__uint_as_float(rr[0]), __uint_as_float(rr[1]));
}
__device__ __forceinline__ void bmask(f32x16& p0, f32x16& p1, int kq, float slope2, float mhat) {
    const float fk = (float)kq;
#pragma unroll
    for (int r = 0; r < 16; ++r) {
        const float d0 = fk + (float)((r & 3) + 8 * (r >> 2)), d1 = d0 + 32.f;
        const float a0 = __builtin_fabsf(d0), a1 = __builtin_fabsf(d1);
        p0[r] = a0 <= 128.f ? p0[r] - __builtin_fmaf(slope2, a0, mhat) : -INFINITY;
        p1[r] = a1 <= 128.f ? p1[r] - __builtin_fmaf(slope2, a1, mhat) : -INFINITY;
    }
}
__device__ __forceinline__ void pv(f32x16* o, int vb, bf16x8 pa0, bf16x8 pa1, bf16x8 pa2, bf16x8 pa3) {
#pragma unroll
    for (int d0 = 0; d0 < 2; ++d0) { s16x4 lo[4], hi[4];
#pragma unroll
        for (int ks = 0; ks < 4; ++ks) {
            asm volatile("ds_read_b64_tr_b16 %0,%1 offset:%c2" : "=&v"(lo[ks]) : "v"(vb), "i"(d0 * 4096 + ks * 1024) : "memory");
            asm volatile("ds_read_b64_tr_b16 %0,%1 offset:%c2" : "=&v"(hi[ks]) : "v"(vb), "i"(d0 * 4096 + ks * 1024 + 512) : "memory"); }
        asm volatile("s_waitcnt lgkmcnt(0)" ::: "memory"); SBAR();
#define PK(k) (bf16x8){lo[k][0], lo[k][1], lo[k][2], lo[k][3], hi[k][0], hi[k][1], hi[k][2], hi[k][3]}
        o[d0] = __builtin_amdgcn_mfma_f32_32x32x16_bf16(pa0, PK(0), o[d0], 0, 0, 0);
        o[d0] = __builtin_amdgcn_mfma_f32_32x32x16_bf16(pa1, PK(1), o[d0], 0, 0, 0);
        o[d0] = __builtin_amdgcn_mfma_f32_32x32x16_bf16(pa2, PK(2), o[d0], 0, 0, 0);
        o[d0] = __builtin_amdgcn_mfma_f32_32x32x16_bf16(pa3, PK(3), o[d0], 0, 0, 0);
#undef PK
    }
}

template <int MODE, int THRL>
__device__ __forceinline__ void attn_unit(const int tid  , int b, int h, int qb, const bf16* Q, const bf16* __restrict__ K, const bf16* __restrict__ V, bf16* O, float* SSQ, float slope2, float sink2, float bound_m0, char* shm, const int S0 = 0, const bool pre = false, const bf16* Khn = nullptr, const bf16* Vhn = nullptr, int* S0n = nullptr) {
    int lane; asm volatile("v_mbcnt_lo_u32_b32 %0, -1, 0\n\tv_mbcnt_hi_u32_b32 %0, -1, %0" : "=v"(lane));
    const int r32 = lane & 31, hi = lane >> 5; const int wid = __builtin_amdgcn_readfirstlane(tid >> 6);
    constexpr int UNITQ = MODE == 1 ? 128 : QB; const int wrow = MODE == 1 ? (wid & 3) : wid;
    const long rowbase = (long)b * SEQ; const int q0 = qb * UNITQ;
    const bf16* Qw = Q + (rowbase + q0 + wrow * QBLK) * QP + h * 64;
    int t0 = 0, NT = SEQ / KVBLK;
    if (MODE == 1) { t0 = 2 * qb - 2; if (t0 < 0) t0 = 0; int t1 = 2 * qb + 4; if (t1 > SEQ / KVBLK) t1 = SEQ / KVBLK; NT = t1 - t0; }
    const bf16* Kh = K + (rowbase + (long)t0 * KVBLK) * KP + (h >> 1) * 64; const bf16* Vh = V + (rowbase + (long)t0 * KVBLK) * KP + (h >> 1) * 64;
    const unsigned lds0 = (unsigned)(uintptr_t)shm;
    float* wsf = (float*)(shm + LDS_WS) + wid * 64;
    const bf16* ksrc = Kh + (long)lane * KP + wid * 8;
    const bf16* vsrc = Vh + (long)(16 * (wid & 3) + (lane >> 2)) * KP + (wid >> 2) * 32 + (lane & 3) * 8;
    const unsigned kdst = lds0 + LDS_K + wid * 1024, vdst = lds0 + LDS_V + wid * 1024;
#define DMA_K(t, slot) glds16(ksrc + (long)(t) * KVBLK * KP, (unsigned)__builtin_amdgcn_readfirstlane(kdst + (slot)))
#define DMA_V(t, slot) glds16(vsrc + (long)(t) * KVBLK * KP, (unsigned)__builtin_amdgcn_readfirstlane(vdst + (slot)))
    const int vb0 = (int)(lds0 + LDS_V) + ((lane >> 4) & 1) * 32 + (lane & 3) * 8 + (4 * hi + ((lane & 15) >> 2)) * 64;
    const char* Kbase = shm + LDS_K; bf16x8 kf[8];
    const lds_cptr shm3 = (lds_cptr)shm; const lds_cptr kp0 = shm3 + LDS_K + hi * 1024 + r32 * 16; const lds_cptr vp0 = shm3 + LDS_V + ((lane >> 4) & 1) * 32 + (lane & 3) * 8 + (4 * hi + ((lane & 15) >> 2)) * 64;
#define ROTV(s) (((s) == (NSLOT - 1) * SLOTB) ? 0 : (s) + SLOTB)
    if (!pre) { DMA_K(0, S0); DMA_V(0, S0); DMA_K(1, ROTV(S0)); }
    bf16x8 qr[4];
#pragma unroll
    for (int d0 = 0; d0 < 4; ++d0) qr[d0] = *reinterpret_cast<const bf16x8*>(&Qw[(long)r32 * QP + d0 * 16 + hi * 8]);
    float mhat = 0.f, l_reg = 0.f; f32x16 o[2]; o[0] = f32x16{}; o[1] = f32x16{}; f32x16 negm = f32x16{};
    if (MODE == 1) { mhat = bound_m0; l_reg = hi == 0 ? __builtin_amdgcn_exp2f(sink2 - bound_m0) : 0.f; }
    if (MODE == 0) { _Pragma("unroll") for (int r = 0; r < 16; ++r) negm[r] = -sink2; asm volatile("" : "+v"(negm)); }
#define NEGM (MODE == 0 ? negm : f32x16{})
    const int kq0 = t0 * KVBLK + 4 * hi - (q0 + wrow * QBLK + r32);
#define CMASK(P0, P1, t) do { if (MODE == 1) bmask(P0, P1, kq0 + (t) * KVBLK, slope2, mhat); } while (0)
    bool resc = false;
#define DECIDE(C0, C1) do { if (false) { \
      float rm = rowmax(C0, C1); resc = false; \
      if (__builtin_expect(__any(rm > (float)THRL), 0)) { const float dl = __builtin_fmaxf(rm, 0.f); mhat += dl; \
        _Pragma("unroll") for (int r = 0; r < 16; ++r) { C0[r] -= dl; C1[r] -= dl; } \
        if (MODE == 0) { _Pragma("unroll") for (int r = 0; r < 16; ++r) negm[r] = -mhat; asm volatile("" : "+v"(negm)); } \
        const float f = __builtin_amdgcn_exp2f(-dl); l_reg *= f; if (hi == 0) wsf[r32] = f; resc = true; } } } while (0)
#define START(P0, P1) do { const float rm = rowmax(P0, P1); resc = false; \
    { const float dl = rm; mhat = fadd_s(mhat, dl); \
      _Pragma("unroll") for (int r = 0; r < 16; ++r) { P0[r] = fsub_s(P0[r], dl); P1[r] = fsub_s(P1[r], dl); } \
      _Pragma("unroll") for (int r = 0; r < 16; ++r) negm[r] = -mhat; asm volatile("" : "+v"(negm)); } } while (0)
#define RESC() do { if (false && resc) { asm volatile("s_waitcnt lgkmcnt(0)" ::: "memory"); \
      _Pragma("unroll") for (int d_ = 0; d_ < 2; ++d_) _Pragma("unroll") for (int r = 0; r < 16; ++r) o[d_][r] *= wsf[crow(r, hi)]; } } while (0)
    f32x16 pA0, pA1, pB0, pB1;
    int sl_prev = S0, sl_cur = S0, sl_next = ROTV(S0);
#define ROT() do { sl_prev = sl_cur; sl_cur = sl_next; sl_next = (sl_next == (NSLOT - 1) * SLOTB) ? 0 : sl_next + SLOTB; } while (0)
    if (!pre) { DMA_K(2, ROTV(ROTV(S0))); WAIT_BAR(3); }
    else asm volatile("s_waitcnt lgkmcnt(0)\n\ts_barrier" ::: "memory");
    qkt(pA0, pA1, Kbase + S0, qr, NEGM, r32, hi); asm volatile("s_nop 15\n\ts_nop 7" : "+v"(pA0), "+v"(pA1));
    if (MODE == 1) { CMASK(pA0, pA1, 0); DECIDE(pA0, pA1); }
#pragma unroll
    for (int r = 0; r < 16; ++r) { pA0[r] = __builtin_amdgcn_exp2f(pA0[r]); pA1[r] = __builtin_amdgcn_exp2f(pA1[r]); }
    WAIT_BAR(0);
    DMA_K(3, S0); DMA_V(1, ROTV(S0));
    ROT();
    kload8(kf, kp0 + sl_cur);
    WAIT_BAR(2);
    s16x4 vlo[8], vhi[8]; u32x4 pw0, pw1, pw2, pw3;
#define PKW(P, B) cvtpk_s(P[B], P[B + 1])
#define PAF(k) __builtin_bit_cast(bf16x8, pw##k)
#define VFR(i) (bf16x8){vlo[i][0], vlo[i][1], vlo[i][2], vlo[i][3], vhi[i][0], vhi[i][1], vhi[i][2], vhi[i][3]}
#define PIN(x) asm volatile("" : "+v"(x))
#define GAPA(MF, A0, A1, A2, A3, W0, W1, PW) do { MF; sacc += A0; sacc += A1; sacc += A2; sacc += A3; PIN(sacc); W0; W1; PIN(PW); SBAR(); } while (0)
#define EX(v) __builtin_amdgcn_exp2f(v)
#define GAPB(MF, X, B) do { MF; X[B] = EX(X[B]); X[B + 1] = EX(X[B + 1]); X[B + 2] = EX(X[B + 2]); X[B + 3] = EX(X[B + 3]); PIN(X); SBAR(); } while (0)
#define VRD(i) do { vlo[i] = vtr(vp_ + (((i) >> 2) * 4096 + ((i) & 3) * 1024)); vhi[i] = vtr(vp_ + (((i) >> 2) * 4096 + ((i) & 3) * 1024 + 512)); } while (0)
#define KRD(G, j) do { if (G) { kload2(kf, kp0 + sl_next, j); SBAR(); } } while (0)
#define STEP(C0, C1, P0, P1, t, GK, GV, GL) do { SBAR(); \
    const lds_cptr vp_ = vp0 + sl_prev; \
    VRD(0); SBAR(); float sacc = (P0[0] + P0[1]); \
    GAPA(C0 = __builtin_amdgcn_mfma_f32_32x32x16_bf16(kf[0], qr[0], NEGM, 0, 0, 0), P0[2], P0[3], P0[4], P0[5],     pw0[0] = PKW(P0, 0), pw0[1] = PKW(P0, 2), pw0); \
    VRD(4); SBAR(); GAPA(C1 = __builtin_amdgcn_mfma_f32_32x32x16_bf16(kf[1], qr[0], NEGM, 0, 0, 0), P0[6], P0[7], P0[8], P0[9],     pw0[2] = PKW(P0, 4), pw0[3] = PKW(P0, 6), pw0); \
    VRD(1); SBAR(); GAPA(C0 = __builtin_amdgcn_mfma_f32_32x32x16_bf16(kf[2], qr[1], C0, 0, 0, 0),   P0[10], P0[11], P0[12], P0[13], pw1[0] = PKW(P0, 8), pw1[1] = PKW(P0, 10), pw1); \
    VRD(5); SBAR(); GAPA(C1 = __builtin_amdgcn_mfma_f32_32x32x16_bf16(kf[3], qr[1], C1, 0, 0, 0),   P0[14], P0[15], P1[0], P1[1],   pw1[2] = PKW(P0, 12), pw1[3] = PKW(P0, 14), pw1); \
    VRD(2); SBAR(); GAPA(C0 = __builtin_amdgcn_mfma_f32_32x32x16_bf16(kf[4], qr[2], C0, 0, 0, 0),   P1[2], P1[3], P1[4], P1[5],     pw2[0] = PKW(P1, 0), pw2[1] = PKW(P1, 2), pw2); \
    VRD(6); SBAR(); GAPA(C1 = __builtin_amdgcn_mfma_f32_32x32x16_bf16(kf[5], qr[2], C1, 0, 0, 0),   P1[6], P1[7], P1[8], P1[9],     pw2[2] = PKW(P1, 4), pw2[3] = PKW(P1, 6), pw2); \
    VRD(3); SBAR(); GAPA(C0 = __builtin_amdgcn_mfma_f32_32x32x16_bf16(kf[6], qr[3], C0, 0, 0, 0),   P1[10], P1[11], P1[12], P1[13], pw3[0] = PKW(P1, 8), pw3[1] = PKW(P1, 10), pw3); \
    VRD(7); SBAR(); GAPA(C1 = __builtin_amdgcn_mfma_f32_32x32x16_bf16(kf[7], qr[3], C1, 0, 0, 0),   P1[14], P1[15], 0.f, 0.f,       pw3[2] = PKW(P1, 12), pw3[3] = PKW(P1, 14), pw3); \
    l_reg += sacc; \
    if (GK) { DMA_K((t) + 3, sl_cur); } if (GV) { DMA_V((t) + 1, sl_next); } \
    CMASK(C0, C1, t); \
    DECIDE(C0, C1); \
    SBAR(); \
    GAPB(o[0] = __builtin_amdgcn_mfma_f32_32x32x16_bf16(PAF(0), VFR(0), o[0], 0, 0, 0), C0, 0); \
    GAPB(o[1] = __builtin_amdgcn_mfma_f32_32x32x16_bf16(PAF(0), VFR(4), o[1], 0, 0, 0), C0, 4); \
    KRD(GL, 0); GAPB(o[0] = __builtin_amdgcn_mfma_f32_32x32x16_bf16(PAF(1), VFR(1), o[0], 0, 0, 0), C0, 8); \
    KRD(GL, 1); GAPB(o[1] = __builtin_amdgcn_mfma_f32_32x32x16_bf16(PAF(1), VFR(5), o[1], 0, 0, 0), C0, 12); \
    KRD(GL, 2); GAPB(o[0] = __builtin_amdgcn_mfma_f32_32x32x16_bf16(PAF(2), VFR(2), o[0], 0, 0, 0), C1, 0); \
    KRD(GL, 3); GAPB(o[1] = __builtin_amdgcn_mfma_f32_32x32x16_bf16(PAF(2), VFR(6), o[1], 0, 0, 0), C1, 4); \
    GAPB(o[0] = __builtin_amdgcn_mfma_f32_32x32x16_bf16(PAF(3), VFR(3), o[0], 0, 0, 0), C1, 8); \
    GAPB(o[1] = __builtin_amdgcn_mfma_f32_32x32x16_bf16(PAF(3), VFR(7), o[1], 0, 0, 0), C1, 12); \
    } while (0)
    int t = 1;
    for (; t + 5 < NT; t += 2) {
        STEP(pB0, pB1, pA0, pA1, t, true, true, true);     WAIT_BAR(2); RESC(); ROT();
        STEP(pA0, pA1, pB0, pB1, t + 1, true, true, true); WAIT_BAR(2); RESC(); ROT();
    }
#define ENDW(tt) do { if ((tt) + 3 < NT) { WAIT_BAR(2); } else if ((tt) + 2 < NT) { WAIT_BAR(1); } else { WAIT_BAR(0); } } while (0)
    for (; t + 1 < NT; t += 2) {
        STEP(pB0, pB1, pA0, pA1, t, (t + 3 < NT), (t + 1 < NT), (t + 1 < NT));       ENDW(t);     RESC(); ROT();
        STEP(pA0, pA1, pB0, pB1, t + 1, (t + 4 < NT), (t + 2 < NT), (t + 2 < NT));   ENDW(t + 1); RESC(); ROT();
    }
    if (Khn) {
        const int s0n = sl_next; *S0n = s0n;
        const bf16* ksn = Khn + (long)lane * KP + wid * 8; const bf16* vsn = Vhn + (long)(16 * (wid & 3) + (lane >> 2)) * KP + (wid >> 2) * 32 + (lane & 3) * 8;
        glds16(ksn, (unsigned)__builtin_amdgcn_readfirstlane(kdst + s0n)); glds16(vsn, (unsigned)__builtin_amdgcn_readfirstlane(vdst + s0n));
        glds16(ksn + (long)KVBLK * KP, (unsigned)__builtin_amdgcn_readfirstlane(kdst + ROTV(s0n))); glds16(ksn + 2L * KVBLK * KP, (unsigned)__builtin_amdgcn_readfirstlane(kdst + ROTV(ROTV(s0n)))); }
    STEP(pB0, pB1, pA0, pA1, NT - 1, false, false, false); RESC();
    { float sacc = pB0[0] + pB0[1];
#pragma unroll
      for (int r = 2; r < 16; ++r) sacc += pB0[r];
#pragma unroll
      for (int r = 0; r < 16; ++r) sacc += pB1[r];
      l_reg += sacc;
      pw0 = (u32x4){PKW(pB0, 0), PKW(pB0, 2), PKW(pB0, 4), PKW(pB0, 6)}; pw1 = (u32x4){PKW(pB0, 8), PKW(pB0, 10), PKW(pB0, 12), PKW(pB0, 14)};
      pw2 = (u32x4){PKW(pB1, 0), PKW(pB1, 2), PKW(pB1, 4), PKW(pB1, 6)}; pw3 = (u32x4){PKW(pB1, 8), PKW(pB1, 10), PKW(pB1, 12), PKW(pB1, 14)};
      SBAR(); pv(o, vb0 + sl_cur, PAF(0), PAF(1), PAF(2), PAF(3)); }
    if (Khn) asm volatile("s_waitcnt vmcnt(0)" ::: "memory");
#undef PKW
#undef PAF
#undef VFR
#undef PIN
#undef GAPA
#undef GAPB
#undef EX
#undef VRD
#undef KRD
#undef STEP
#undef ENDW
    { auto rr = __builtin_amdgcn_permlane32_swap(__float_as_uint(l_reg), __float_as_uint(l_reg), false, false); l_reg = __uint_as_float(rr[0]) + __uint_as_float(rr[1]); }
    if (hi == 0) wsf[32 + r32] = l_reg; asm volatile("s_waitcnt lgkmcnt(0)" ::: "memory");
    float rli[16];
#pragma unroll
    for (int r = 0; r < 16; ++r) rli[r] = __builtin_amdgcn_rcpf(wsf[32 + crow(r, hi)]);
    const long orow0 = rowbase + q0 + wrow * QBLK;
    bf16* Ow = O + orow0 * OP + h * 64;
    { bf16* stg = (bf16*)(shm + LDS_OST) + wid * 2048;
#pragma unroll
      for (int r = 0; r < 16; ++r) { const int orow = crow(r, hi);
#pragma unroll
        for (int d0 = 0; d0 < 2; ++d0) stg[orow * 64 + d0 * 32 + r32] = (bf16)f2bf(o[d0][r] * rli[r]); }
      asm volatile("s_waitcnt lgkmcnt(0)" ::: "memory");
#pragma unroll
      for (int i = 0; i < 4; ++i) { const int row = i * 8 + (lane >> 3), ch = lane & 7; const u32x4 v = *(const u32x4*)(stg + row * 64 + ch * 8);
        *(u32x4*)(Ow + (long)row * OP + ch * 8) = v;
        float ss = 0.f;
#pragma unroll
        for (int e = 0; e < 4; ++e) { const float a = bf2f(v[e] & 0xffffu), c = bf2f(v[e] >> 16); ss += a * a + c * c; }
        ss = sum8(ss);
        if (ch == 0) SSQ[(orow0 + row) * 4 + h] = ss; } }
    asm volatile("s_waitcnt lgkmcnt(0)\n\ts_barrier" ::: "memory");
#undef NEGM
#undef DMA_K
#undef DMA_V
#undef CMASK
#undef DECIDE
#undef START
#undef RESC
#undef ROT
#undef ROTV
}
#undef SBAR
#undef WAIT_BAR
}

struct EpiXend {
    float* xend;
    __device__ __forceinline__ void operator()(f32x4 (&acc)[2][2][4][2], const g8::Unit& u, int wr, int wc, int fr, int fq, LAS unsigned char* es) const {
#pragma unroll
        for (int ai = 0; ai < 2; ++ai)
#pragma unroll
            for (int m = 0; m < 4; ++m) { const int row = u.pm * 256 + ai * 128 + wr * 64 + m * 16 + fr; float* rp = xend + ((size_t)u.a0 * 1024 + row) * 256 + wc * 32 + 8 * fq;
#pragma unroll
                for (int bj = 0; bj < 2; ++bj)
#pragma unroll
                    for (int n = 0; n < 2; ++n) *(f32x4*)(rp + bj * 128 + 4 * n) = acc[ai][bj][m][n]; }
    }
};

__device__ __forceinline__ void phase_attn_a(Frame& F, int l) {
    unsigned char* ws = F.ws;
    const float m0a = ((const float*)(ws + WS_W + (size_t)l * WL_SIZE + WL_SINK))[8];
    char* shm = F.ldsg;
    for (int i = 0; i < (F.G == 256 ? 2 : 512); ++i) {
        int bk, w;
        if (F.G == 256) { bk = (F.vcu >> 5) * 2 + i; w = F.vcu & 31; }
        else { const int u = F.vcu + i * F.G; if (u >= 512) break; bk = u >> 5; w = u & 31; }
        const int b = bk >> 1, h = (bk & 1) * 2 + (w >> 4), qb = w & 15;
        att::attn_unit<0, 8>(F.tid, b, h, qb, (const bf16*)(ws + WS_QA), (const bf16*)(ws + WS_KA), (const bf16*)(ws + WS_VA), (bf16*)(ws + WS_MIX), (float*)(ws + WS_SSQA), 0.f, m0a, 0.f, shm);
    }
}
__device__ __forceinline__ void phase_attn_b(Frame& F, int l) {
    unsigned char* ws = F.ws; unsigned char* wl = ws + WS_W + (size_t)l * WL_SIZE;
    char* shm = F.ldsg;
    for (int i = 0; i < (F.G == 256 ? 3 : 512); ++i) {
        int b, u;
        if (F.G == 256) { const int sub = F.vcu & 31; b = F.vcu >> 5; if (sub < 16) u = i * 16 + sub; else { if (i > 0) break; u = 48 + (sub - 16); } }
        else { const int uu = F.vcu + i * F.G; if (uu >= 512) break; b = uu >> 6; u = uu & 63; }
        const int kvh = u >> 5, qb = u & 31, h = kvh * 2 + (F.wave >> 2);
        const float slope2 = exp2f(-2.f * (float)(h + 1)) * LOG2E; const float sink2 = ((const float*)(wl + WL_SINK))[h];
        att::attn_unit<1, 8>(F.tid, b, h, qb, (const bf16*)(ws + WS_QB), (const bf16*)(ws + WS_KB), (const bf16*)(ws + WS_VB), (bf16*)(ws + WS_MIX) + 256, (float*)(ws + WS_SSQB), slope2, sink2, fmaxf(((const float*)(wl + WL_SINK))[9], fmaxf(sink2 - 20.f, 0.f)), shm);
    }
}


__device__ __forceinline__ void phase_attn_ab(Frame& F, int l) {
    unsigned char* ws = F.ws; unsigned char* wl = ws + WS_W + (size_t)l * WL_SIZE;
    char* shm = F.ldsg;
    const float m0a = ((const float*)(wl + WL_SINK))[8];
    const int sub = F.vcu & 31, xb_ = F.vcu >> 5, nun = 2 + (sub < 16 ? 3 : 1);
    const bf16* KA = (const bf16*)(ws + WS_KA); const bf16* VA = (const bf16*)(ws + WS_VA); const bf16* KB = (const bf16*)(ws + WS_KB); const bf16* VB = (const bf16*)(ws + WS_VB);
    int S0 = 0; bool pre = false;
    for (int i = 0; i < nun; ++i) {
        int md, b, hs, qb;
        if (i < 2) { const int bk = xb_ * 2 + i; md = 0; b = bk >> 1; hs = (bk & 1) * 2 + (sub >> 4); qb = sub & 15; }
        else { const int j = i - 2, u = sub < 16 ? j * 16 + sub : 48 + (sub - 16); md = 1; b = xb_; hs = u >> 5; qb = u & 31; }
        const bf16* Khn = nullptr; const bf16* Vhn = nullptr;
        if (i + 1 < nun) { const int i1 = i + 1;
            if (i1 < 2) { const int bk = xb_ * 2 + i1, b1 = bk >> 1, h1 = (bk & 1) * 2 + (sub >> 4); Khn = KA + ((long)b1 * SEQ) * att::KP + (h1 >> 1) * 64; Vhn = VA + ((long)b1 * SEQ) * att::KP + (h1 >> 1) * 64; }
            else { const int j = i1 - 2, u = sub < 16 ? j * 16 + sub : 48 + (sub - 16), kvh = u >> 5, q1 = u & 31; int t0 = 2 * q1 - 2; if (t0 < 0) t0 = 0;
                Khn = KB + ((long)xb_ * SEQ + (long)t0 * att::KVBLK) * att::KP + kvh * 64; Vhn = VB + ((long)xb_ * SEQ + (long)t0 * att::KVBLK) * att::KP + kvh * 64; } }
        int S0n = 0;
        if (md == 0) att::attn_unit<0, 8>(F.tid, b, hs, qb, (const bf16*)(ws + WS_QA), KA, VA, (bf16*)(ws + WS_MIX), (float*)(ws + WS_SSQA), 0.f, m0a, 0.f, shm, S0, pre, Khn, Vhn, &S0n);
        else { const int h = hs * 2 + (F.wave >> 2); const float slope2 = exp2f(-2.f * (float)(h + 1)) * LOG2E; const float sink2 = ((const float*)(wl + WL_SINK))[h];
            att::attn_unit<1, 8>(F.tid, b, h, qb, (const bf16*)(ws + WS_QB), KB, VB, (bf16*)(ws + WS_MIX) + 256, (float*)(ws + WS_SSQB), slope2, sink2, fmaxf(((const float*)(wl + WL_SINK))[9], fmaxf(sink2 - 20.f, 0.f)), shm, S0, pre, Khn, Vhn, &S0n); }
        S0 = S0n; pre = true;
    }
}
__device__ __forceinline__ void scan_unit(Frame& F, int l, int g, int b, int dir) {
    unsigned char* ws = F.ws; unsigned char* wl = ws + WS_W + (size_t)l * WL_SIZE;
    const float* XE = (const float*)(ws + WS_XEND); bf16* UX = (bf16*)(ws + WS_UX);
    LAS f32x2* E = (LAS f32x2*)F.lds;
    const int p = F.tid & 63, kg = F.tid >> 6;
    {
        const f32x2 a1 = ((const f32x2*)(wl + WL_A32))[(dir * NG + g) * 64 + p];
        const size_t rowb = (size_t)g * 1024 + b * NCH;
        float xr[16], xi[16];
#pragma unroll
        for (int i = 0; i < 16; ++i) { const int cc = kg * 16 + i, c = dir ? (NCH - 1 - cc) : cc; const float* q = XE + (rowb + c) * 256 + dir * 128 + p; xr[i] = q[0]; xi[i] = q[64]; }
#pragma unroll
        for (int i = 1; i < 16; ++i) { const float nr = a1.x * xr[i - 1] - a1.y * xi[i - 1] + xr[i], ni = a1.x * xi[i - 1] + a1.y * xr[i - 1] + xi[i]; xr[i] = nr; xi[i] = ni; }
        __syncthreads();
        E[kg * 64 + p] = (f32x2){xr[15], xi[15]};
        __syncthreads();
        f32x2 a16 = a1;
#pragma unroll
        for (int i = 0; i < 4; ++i) a16 = (f32x2){a16.x * a16.x - a16.y * a16.y, 2.f * a16.x * a16.y};
        float cr = 0.f, ci = 0.f;
        for (int j = 0; j < kg; ++j) { const f32x2 e = E[j * 64 + p]; const float nr = a16.x * cr - a16.y * ci + e.x, ni = a16.x * ci + a16.y * cr + e.y; cr = nr; ci = ni; }
        float pr_ = 1.f, pi_ = 0.f;
#pragma unroll
        for (int i = 0; i < 16; ++i) {
            float er, ei;
            if (i == 0) { er = cr; ei = ci; }
            else { er = xr[i - 1] + (pr_ * cr - pi_ * ci); ei = xi[i - 1] + (pr_ * ci + pi_ * cr); }
            const int cc = kg * 16 + i, c = dir ? (NCH - 1 - cc) : cc;
            bf16* q = UX + (rowb + c) * UXP + 512 + dir * 128 + p;
            q[0] = (bf16)f2bf(er); q[64] = (bf16)f2bf(ei);
            const float npr = pr_ * a1.x - pi_ * a1.y, npi = pr_ * a1.y + pi_ * a1.x; pr_ = npr; pi_ = npi;
        }
    }
}
constexpr int CW_DEP2 = 12800;
__device__ __forceinline__ void phase_s5a(Frame& F, int l) {
    unsigned char* ws = F.ws;
    const int sub = F.vcu & 31; if (sub >= 16) return;
    const int idx = F.G == 256 ? (16 * ((F.vcu >> 5) & 1) + sub) * 4 + (F.vcu >> 6) : (F.vcu >> 5) * 16 + sub;
    int samex;
    {   const unsigned mine = (unsigned)__builtin_amdgcn_s_getreg((3 << 11) | 20) & 0xFu;
        const unsigned v = ((const unsigned*)ws)[7168 + (F.lane & 31) * 8 + ((int)blockIdx.x & 7)];
        samex = (F.G == 256 && __builtin_amdgcn_ballot_w64(v != mine) == 0ull) ? 1 : 0; }
    SchedGrid S{(unsigned)WS_UX, (unsigned)(WS_W + (size_t)l * WL_SIZE + WL_S5B1), UXP * 2, 512 * 2, 1024u * UXP * 2u, 256u * 512u * 2u, 4, 1, 8, NG, 1 << 20, idx};
    EpiXend E{(float*)(ws + WS_XEND)};
    g8::gemm_phase(F.lds, F.tid, F.ws, S, E);
    if (idx >= NG * 4) return;
    asm volatile("s_waitcnt vmcnt(0)" ::: "memory");
    __syncthreads();
    if (F.wave == 0) { __builtin_amdgcn_fence(__ATOMIC_ACQUIRE, "agent"); asm volatile("s_waitcnt vmcnt(0)" ::: "memory"); }
    __syncthreads();
    const int g = idx >> 2, pm = idx & 3;
    for (int q = 0; q < 4; ++q) scan_unit(F, l, g, 2 * pm + (q >> 1), q & 1);
    asm volatile("s_waitcnt vmcnt(0)" ::: "memory");
    __syncthreads();
    if (F.tid == 0) { if (!samex) { __builtin_amdgcn_fence(__ATOMIC_RELEASE, "agent"); asm volatile("s_waitcnt vmcnt(0)" ::: "memory"); }
        __hip_atomic_fetch_add((unsigned*)ws + CW_DEP2 + l * 128 + idx, 32u, __ATOMIC_RELAXED, __HIP_MEMORY_SCOPE_AGENT); }
}
__device__ __forceinline__ float gelu_tanh_f(float v) {
    const float w = __builtin_fmaf(v * v, -2.302208198f * 0.044715f, -2.302208198f);
    return v * __builtin_amdgcn_rcpf(1.f + __builtin_amdgcn_exp2f(v * w));
}
struct EpiS5Y {
    bf16* yc;
    __device__ __forceinline__ void operator()(f32x4 (&acc)[2][2][4][2], const g8::Unit& u, int wr, int wc, int fr, int fq, LAS unsigned char* es) const {
        const int g = u.a0;
#pragma unroll
        for (int ai = 0; ai < 2; ++ai)
#pragma unroll
            for (int m = 0; m < 4; ++m) { const int R = u.pm * 256 + ai * 128 + wr * 64 + m * 16 + fr, b = R >> 7, c = R & 127;
#pragma unroll
                for (int bj = 0; bj < 2; ++bj) { const int n = u.pn * 256 + bj * 128 + wc * 32 + 8 * fq, tl = n >> 4, h0 = n & 15;
                    const size_t tok = (size_t)b * SEQ + c * CH + tl; const f32x4 v0 = acc[ai][bj][m][0], v1 = acc[ai][bj][m][1];
                    u32x4 w; w.x = pk2(gelu_tanh_f(v0.x), gelu_tanh_f(v0.y)); w.y = pk2(gelu_tanh_f(v0.z), gelu_tanh_f(v0.w)); w.z = pk2(gelu_tanh_f(v1.x), gelu_tanh_f(v1.y)); w.w = pk2(gelu_tanh_f(v1.z), gelu_tanh_f(v1.w));
                    *(u32x4*)(yc + tok * CW + g * GC + h0) = w; } }
    }
};
struct SchedS5b {
    unsigned A, B; int l, sb; int gsel = -1, pmsel = 0;
    __device__ __forceinline__ bool next(int i, g8::Unit& u) const {
        if (sb < 0 || i >= 2) return false;
        const int L = gsel >= 0 ? gsel * 8 + pmsel * 2 + i : 2 * sb + i; if (L >= NG * 8) return false;
        const int g = L >> 3, pm = (L & 7) >> 1, pn = L & 1;
        u.A = A + (unsigned)g * (1024u * UXP * 2u) + (unsigned)pm * 256u * (UXP * 2u); u.B = B + (unsigned)g * (512u * UXP * 2u) + (unsigned)pn * 256u * (UXP * 2u); u.lda = UXP * 2; u.ldb = UXP * 2; u.nt = 12; u.fin = 1;
        u.rows = nullptr; u.nv = 0; u.pm = pm; u.pn = pn; u.a0 = g; u.r0 = 0; u.kind = 0; u.dep = CW_DEP2 + l * 128 + g * 4 + pm; u.B2 = 0; return true;
    }
};
__device__ __forceinline__ void phase_s5b(Frame& F, int l) {
    unsigned char* ws = F.ws;
    const int sub = F.vcu & 31;
    SchedS5b S{(unsigned)WS_UX, (unsigned)(WS_W + (size_t)l * WL_SIZE + WL_S5B2), l, sub >= 16 ? (F.vcu >> 5) * 16 + (sub - 16) : -1, (F.G == 256 && sub >= 16) ? 16 * ((F.vcu >> 5) & 1) + (sub - 16) : -1, F.vcu >> 6};
    EpiS5Y E{(bf16*)(ws + WS_YC)};
    g8::gemm_phase(F.lds, F.tid, F.ws, S, E);
}

struct EpiGlu {
    unsigned char* ws; int l;
    __device__ __forceinline__ void operator()(f32x4 (&acc)[2][2][4][2], const g8::Unit& u, int wr, int wc, int fr, int fq, LAS unsigned char* es) const {
        const bf16* yc = (const bf16*)(ws + WS_YC); bf16* mix = (bf16*)(ws + WS_MIX); float* ssc = (float*)(ws + WS_SSQC);
        const float* gb = (const float*)(ws + WS_W + (size_t)l * WL_SIZE + WL_GLUB);
        f32x4 bv[2][2];
#pragma unroll
        for (int bj = 0; bj < 2; ++bj)
#pragma unroll
            for (int n = 0; n < 2; ++n) bv[bj][n] = *(const f32x4*)(gb + u.pn * 256 + bj * 128 + wc * 32 + 8 * fq + 4 * n);
#pragma unroll
        for (int ai = 0; ai < 2; ++ai) {
            u32x4 yv[4][2];
#pragma unroll
            for (int m = 0; m < 4; ++m)
#pragma unroll
                for (int bj = 0; bj < 2; ++bj) yv[m][bj] = *(const u32x4*)(yc + ((size_t)u.pm * 256 + ai * 128 + wr * 64 + m * 16 + fr) * CW + u.pn * 256 + bj * 128 + wc * 32 + 8 * fq);
#pragma unroll
            for (int m = 0; m < 4; ++m) { const size_t row = (size_t)u.pm * 256 + ai * 128 + wr * 64 + m * 16 + fr; float ss = 0.f;
#pragma unroll
                for (int bj = 0; bj < 2; ++bj) { const int col = u.pn * 256 + bj * 128 + wc * 32 + 8 * fq; float o[8];
#pragma unroll
                    for (int n = 0; n < 2; ++n)
#pragma unroll
                        for (int j = 0; j < 4; ++j) { const float a = acc[ai][bj][m][n][j] + bv[bj][n][j]; const float gate = __builtin_amdgcn_rcpf(1.f + __builtin_amdgcn_exp2f(-a * LOG2E));
                            const unsigned yw = yv[m][bj][n * 2 + (j >> 1)]; const float y = bf2f((j & 1) ? (yw >> 16) : (yw & 0xffffu)); o[n * 4 + j] = y * gate; }
                    u32x4 w; w.x = pk2(o[0], o[1]); w.y = pk2(o[2], o[3]); w.z = pk2(o[4], o[5]); w.w = pk2(o[6], o[7]);
                    *(u32x4*)(mix + row * 1024 + 512 + col) = w;
#pragma unroll
                    for (int e = 0; e < 4; ++e) { const float a = bf2f(w[e] & 0xffffu), c = bf2f(w[e] >> 16); ss += a * a + c * c; } }
                ss = sum_xor32(sum_xor16(ss));
                if (fq == 0) ssc[row * 8 + u.pn * 4 + wc] = ss; } }
    }
};
__device__ __forceinline__ void phase_glu(Frame& F, int l) {
    unsigned char* ws = F.ws; unsigned char* wl = ws + WS_W + (size_t)l * WL_SIZE;
    SchedGrid S{(unsigned)WS_YC, (unsigned)(WS_W + (size_t)l * WL_SIZE + WL_WGLU), CW * 2, CW * 2, 0, 0, T / 256, 2, 8, 1, F.G, (int)blockIdx.x};
    EpiGlu E{ws, l};
    g8::gemm_phase(F.lds, F.tid, F.ws, S, E);
}

struct SchedOutProj {
    unsigned A, B; int G, c;
    __device__ __forceinline__ bool next(int i, g8::Unit& u) const {
        const int j = i / 3, seg = i - 3 * j, L = j * G + c; int pm, pn; if (!g8::tile_order(L, T / 256, DM / 256, pm, pn)) return false;
        const unsigned off = seg == 0 ? 0u : (seg == 1 ? 512u : 1024u);
        u.A = A + (unsigned)pm * 256u * 2048u + off; u.B = B + (unsigned)pn * 256u * 2048u + off; u.lda = 2048; u.ldb = 2048; u.nt = seg == 2 ? 8 : 4; u.fin = seg == 2; u.rows = nullptr; u.nv = 0; u.pm = pm; u.pn = pn; u.a0 = seg; u.r0 = 0; u.kind = 0; u.dep = -1; u.B2 = 0; return true;
    }
};
struct EpiOutProj {
    unsigned char* ws;
    __device__ __forceinline__ void operator()(f32x4 (&acc)[2][2][4][2], const g8::Unit& u, int wr, int wc, int fr, int fq, LAS unsigned char* es) const {
        const float* ssa = (const float*)(ws + WS_SSQA); const float* ssb = (const float*)(ws + WS_SSQB); const float* ssc = (const float*)(ws + WS_SSQC);
        bf16* xb = (bf16*)(ws + WS_XB);
        const int seg = u.a0;
        LAS float* fs = (LAS float*)es;
        if (seg == 0) {
            const int ln = fr + 16 * fq;
#pragma unroll
            for (int h = 0; h < 2; ++h) { const size_t row = (size_t)u.pm * 256 + h * 128 + wr * 64 + ln;
                const f32x4 a = *(const f32x4*)(ssa + row * 4), b = *(const f32x4*)(ssb + row * 4), c0 = *(const f32x4*)(ssc + row * 8), c1 = *(const f32x4*)(ssc + row * 8 + 4);
                const float ma = ((a.x + a.y) + (a.z + a.w)) * (1.f / 256.f) + EPS, mb = ((b.x + b.y) + (b.z + b.w)) * (1.f / 256.f) + EPS, mc = (((c0.x + c0.y) + (c0.z + c0.w)) + ((c1.x + c1.y) + (c1.z + c1.w))) * (1.f / 512.f) + EPS;
                const float ra = rsqrtf(ma), rb = rsqrtf(mb), rc = rsqrtf(mc);
                fs[64 * h + ln] = ra * sqrtf(mb); fs[128 + 64 * h + ln] = rb * sqrtf(mc); fs[256 + 64 * h + ln] = rc; }
            asm volatile("s_waitcnt lgkmcnt(0)" ::: "memory");
        }
        if (seg < 2) {
#pragma unroll
            for (int ai = 0; ai < 2; ++ai)
#pragma unroll
                for (int m = 0; m < 4; ++m) { const float f = fs[128 * seg + 64 * ai + 16 * m + fr];
#pragma unroll
                    for (int bj = 0; bj < 2; ++bj)
#pragma unroll
                        for (int n = 0; n < 2; ++n) acc[ai][bj][m][n] = acc[ai][bj][m][n] * f; }
        } else {
#pragma unroll
            for (int ai = 0; ai < 2; ++ai) {
                u32x4 xo[4][2];
#pragma unroll
                for (int m = 0; m < 4; ++m)
#pragma unroll
                    for (int bj = 0; bj < 2; ++bj) xo[m][bj] = *(const u32x4*)(xb + ((size_t)u.pm * 256 + ai * 128 + wr * 64 + m * 16 + fr) * DM + u.pn * 256 + bj * 128 + wc * 32 + 8 * fq);
#pragma unroll
                for (int m = 0; m < 4; ++m) { const size_t row = (size_t)u.pm * 256 + ai * 128 + wr * 64 + m * 16 + fr; const float f = fs[256 + 64 * ai + 16 * m + fr];
#pragma unroll
                    for (int bj = 0; bj < 2; ++bj) { const size_t off = row * DM + u.pn * 256 + bj * 128 + wc * 32 + 8 * fq; const u32x4 x = xo[m][bj];
                        const f32x4 x0 = (f32x4){bf2f(x.x & 0xffffu), bf2f(x.x >> 16), bf2f(x.y & 0xffffu), bf2f(x.y >> 16)}, x1 = (f32x4){bf2f(x.z & 0xffffu), bf2f(x.z >> 16), bf2f(x.w & 0xffffu), bf2f(x.w >> 16)};
                        const f32x4 v0 = x0 + acc[ai][bj][m][0] * f, v1 = x1 + acc[ai][bj][m][1] * f;
                        u32x4 w; w.x = pk2(v0.x, v0.y); w.y = pk2(v0.z, v0.w); w.z = pk2(v1.x, v1.y); w.w = pk2(v1.z, v1.w);
                        *(u32x4*)(xb + off) = w; } } }
        }
    }
};
__device__ __forceinline__ void phase_outproj(Frame& F, int l) {
    unsigned char* ws = F.ws; unsigned char* wl = ws + WS_W + (size_t)l * WL_SIZE;
    SchedOutProj S{(unsigned)WS_MIX, (unsigned)(WS_W + (size_t)l * WL_SIZE + WL_WOUT), F.G, (int)blockIdx.x};
    EpiOutProj E{ws};
    g8::gemm_phase(F.lds, F.tid, F.ws, S, E);
}


constexpr size_t WS_TOKB = 6 * MiB;
constexpr size_t WS_TOKR = 6 * MiB + 128 * 1024;
constexpr size_t WS_R2 = 6 * MiB + 256 * 1024;
constexpr size_t WS_TOKW = 6 * MiB + 384 * 1024;
constexpr size_t WS_CNT = 6 * MiB + 640 * 1024;
constexpr size_t WS_BTAB = 6 * MiB + 680 * 1024;
constexpr int BCAP = T;
constexpr size_t WS_ROWG = WS_YTMP;
constexpr size_t WS_ROWW = WS_YTMP + 4 * MiB;
constexpr int CW_BCNT = 8192;
constexpr size_t WS_ACT = WS_QA;
constexpr int NBKT = 24, MAXROWS = T + NBKT * 256;
static_assert((size_t)NBKT * BCAP * 4 <= 4 * MiB && WS_ROWW + (size_t)NBKT * BCAP * 16 <= WS_YTMP + 64 * MiB && (size_t)MAXROWS * 512 * 2 <= 64 * MiB, "moe ws map");

__device__ __forceinline__ void phase_router(Frame& F, int l) {
    unsigned char* ws = F.ws; unsigned char* wl = ws + WS_W + (size_t)l * WL_SIZE;
    constexpr int WP = 2064;
    LAS unsigned char* wimg = F.lds;
    LAS float* lgs = (LAS float*)(F.lds + 48 * WP);
    constexpr int RB0 = 48 * WP + 128 * 20 * 4;
    LAS int* tb = (LAS int*)(F.lds + RB0); LAS f32x2* tw = (LAS f32x2*)(F.lds + RB0 + 512); LAS float* tr2 = (LAS float*)(F.lds + RB0 + 1536);
    {   const u32x4* src = (const u32x4*)(wl + WL_WR); u32x4 wv[12];
#pragma unroll
        for (int k = 0; k < 12; ++k) wv[k] = src[F.tid + k * NTHR];
#pragma unroll
        for (int k = 0; k < 12; ++k) { const int i = F.tid + k * NTHR; *(LAS u32x4*)(wimg + (i >> 7) * WP + (i & 127) * 16) = wv[k]; } }
    const float* rb = (const float*)(wl + WL_RB);
    const bf16* X = (const bf16*)(ws + WS_XB);
    __syncthreads();
    for (int tile = F.vcu; tile < T / 128; tile += F.G) {
        {   const int tk = F.lane & 15, kc = F.lane >> 4;
            const bf16* xrow = X + ((size_t)tile * 128 + F.wave * 16 + tk) * DM + 8 * kc;
            const LAS unsigned char* wrow = wimg + tk * WP + kc * 16;
            f32x4 acc0 = (f32x4){0.f, 0.f, 0.f, 0.f}, acc1 = acc0, acc2 = acc0; float ss = 0.f;
            u32x4 xv2[2][16];
#pragma unroll
            for (int hb = 0; hb < 2; ++hb)
#pragma unroll
                for (int i = 0; i < 16; ++i) xv2[hb][i] = *(const u32x4*)(xrow + (hb * 16 + i) * 32);
#pragma unroll
            for (int hb = 0; hb < 2; ++hb) { u32x4 (&xv)[16] = xv2[hb];
#pragma unroll
                for (int i = 0; i < 16; ++i) { const int ks = hb * 16 + i; const bf16x8 xb8 = __builtin_bit_cast(bf16x8, xv[i]);
                    const bf16x8 w0 = *(const LAS bf16x8*)(wrow + ks * 64), w1 = *(const LAS bf16x8*)(wrow + 16 * WP + ks * 64), w2 = *(const LAS bf16x8*)(wrow + 32 * WP + ks * 64);
                    acc0 = __builtin_amdgcn_mfma_f32_16x16x32_bf16(w0, xb8, acc0, 0, 0, 0); acc1 = __builtin_amdgcn_mfma_f32_16x16x32_bf16(w1, xb8, acc1, 0, 0, 0); acc2 = __builtin_amdgcn_mfma_f32_16x16x32_bf16(w2, xb8, acc2, 0, 0, 0);
#pragma unroll
                    for (int e = 0; e < 4; ++e) { const float a = bf2f(xv[i][e] & 0xffffu), c = bf2f(xv[i][e] >> 16); ss += a * a + c * c; } } }
            ss = sum_xor32(sum_xor16(ss));
            const int ti = F.wave * 16 + tk; LAS float* lr = lgs + ti * 20 + 2 * kc;
            lr[0] = acc0[0] + acc0[1]; lr[1] = acc0[2] + acc0[3]; lr[8] = acc1[0] + acc1[1]; lr[9] = acc1[2] + acc1[3];
            if (kc < 2) { lr[16] = acc2[0] + acc2[1]; lr[17] = acc2[2] + acc2[3]; }
            if (kc == 0) tr2[ti] = rsqrtf(ss * (1.f / DM) + EPS);
        }
        __syncthreads();
        if (F.tid < 128) { const int ti = F.tid; const float r2 = tr2[ti]; const LAS float* lg = lgs + ti * 20;
            float cj[4];
#pragma unroll
            for (int j2 = 0; j2 < 4; ++j2) cj[j2] = lg[j2] * r2 + rb[j2];
            int g = 0; float mx = cj[0];
#pragma unroll
            for (int j2 = 1; j2 < 4; ++j2) if (cj[j2] > mx) { mx = cj[j2]; g = j2; }
            float se = 0.f;
#pragma unroll
            for (int j2 = 0; j2 < 4; ++j2) se += __expf(cj[j2] - mx);
            const float top_p = 1.f / se;
            const float f0 = lg[4 + g * 4] * r2 + rb[4 + g * 4], f1 = lg[5 + g * 4] * r2 + rb[5 + g * 4], f2 = lg[6 + g * 4] * r2 + rb[6 + g * 4], f3 = lg[7 + g * 4] * r2 + rb[7 + g * 4];
            int i1 = 0; float v1 = f0; if (f1 > v1) { v1 = f1; i1 = 1; } if (f2 > v1) { v1 = f2; i1 = 2; } if (f3 > v1) { v1 = f3; i1 = 3; }
            int i2 = -1; float v2 = -3.0e38f;
            if (i1 != 0 && f0 > v2) { v2 = f0; i2 = 0; } if (i1 != 1 && f1 > v2) { v2 = f1; i2 = 1; } if (i1 != 2 && f2 > v2) { v2 = f2; i2 = 2; } if (i1 != 3 && f3 > v2) { v2 = f3; i2 = 3; }
            const float e2 = __expf(v2 - v1); const float w1 = top_p / (1.f + e2), w2 = top_p * e2 / (1.f + e2);
            const int lo = i1 < i2 ? i1 : i2, hi = i1 < i2 ? i2 : i1; const int pr = lo == 0 ? hi - 1 : (lo == 1 ? hi + 1 : 5);
            tb[ti] = g * 6 + pr; tw[ti] = i1 < i2 ? (f32x2){w1, w2} : (f32x2){w2, w1}; }
        __syncthreads();
        LAS int* toff = (LAS int*)(F.lds + RB0 + 2048);
        if (F.tid < 32) { const int b = F.tid; int c = 0; for (int t2 = 0; t2 < 128; ++t2) c += (tb[t2] == b) ? 1 : 0;
            toff[b] = (b < NBKT && c > 0) ? (int)atomicAdd((unsigned*)ws + CW_BCNT + l * 32 + b, (unsigned)c) : 0; }
        int bk = 0, rank = 0;
        if (F.tid < 128) { bk = tb[F.tid]; for (int t2 = 0; t2 < F.tid; ++t2) rank += (tb[t2] == bk) ? 1 : 0; }
        __syncthreads();
        if (F.tid < 128) { const size_t tok = (size_t)tile * 128 + F.tid; const size_t pos = (size_t)bk * BCAP + toff[bk] + rank;
            ((int*)(ws + WS_ROWG))[pos] = (int)tok; const f32x2 w2 = tw[F.tid]; ((f32x4*)(ws + WS_ROWW))[pos] = (f32x4){w2.x, w2.y, tr2[F.tid], 0.f}; }
        __syncthreads();
    }
}
constexpr int LDS_BTAB = LDS_MISC - 16 - 512;
__device__ __forceinline__ void moe_table(Frame& F, int l) {
    LAS int* tabl = (LAS int*)(F.lds + LDS_BTAB);
    __syncthreads();
    if (F.tid < 32) tabl[F.tid] = F.tid < NBKT ? (int)__hip_atomic_load((unsigned*)F.ws + CW_BCNT + l * 32 + F.tid, __ATOMIC_RELAXED, __HIP_MEMORY_SCOPE_AGENT) : 0;
    __syncthreads();
    if (F.tid == 0) { int s = 0; for (int j = 0; j < NBKT; ++j) { tabl[32 + j] = s; s += (tabl[j] + 255) >> 8; } tabl[32 + NBKT] = s; }
    __syncthreads();
}
__device__ __forceinline__ bool moe_bucket(const LAS int* tabl, int pm, int& elo, int& ehi, int& r0, int& nv) {
    if (pm >= tabl[32 + NBKT]) return false;
    int b = 0;
    for (int j = 1; j < NBKT; ++j) b += (tabl[32 + j] <= pm) ? 1 : 0;
    b = __builtin_amdgcn_readfirstlane(b);
    const int lt = pm - __builtin_amdgcn_readfirstlane(tabl[32 + b]), tot = __builtin_amdgcn_readfirstlane(tabl[b]);
    const int g = b / 6, pr = b - 6 * g; const int lo = pr < 3 ? 0 : (pr < 5 ? 1 : 2), hi = pr < 3 ? pr + 1 : (pr < 5 ? pr - 1 : 3);
    elo = g * 4 + lo; ehi = g * 4 + hi; r0 = b * BCAP + lt * 256; nv = tot - lt * 256; if (nv > 256) nv = 256; return true;
}
constexpr int CW_XCC = 7168;
constexpr int CW_DEP = 12288;
struct SchedMoe {
    unsigned char* ws; unsigned wgu, wdn; const LAS int* tabl; int l, G, c;
    __device__ __forceinline__ bool next(int i, g8::Unit& u) const {
        const int MT = __builtin_amdgcn_readfirstlane(tabl[32 + NBKT]);
        const int x = c & 7, cx = c >> 3, W = G >> 3;
        const int mq = MT >> 3, mr = MT & 7, m0 = x * mq + (x < mr ? x : mr), U = 4 * (mq + (x < mr ? 1 : 0));
        int ngu = 0; if (cx < U) ngu = (U - cx + W - 1) / W;
        int off, kind, seg = 0;
        if (i < ngu) { off = i * W + cx; kind = 0; }
        else { const int k = i - ngu; seg = 1; kind = 1;
            int rem = U - 2 * W; rem = rem < 0 ? 0 : rem; if (rem > W - 1) rem = W - 1;
            if (k == 0) off = cx; else { if (cx < rem) return false; off = W + (cx - rem) + (k - 1) * (W - rem); } }
        if (off >= U) return false;
        const int pm = m0 + (off >> 2), pn = off & 3;
        int elo, ehi, r0, nv; if (!moe_bucket(tabl, pm, elo, ehi, r0, nv)) return false;
        const bool gu = kind == 0; const int e = pn < 2 ? elo : ehi;
        const unsigned uA = gu ? (unsigned)WS_XB : (unsigned)WS_ACT + (unsigned)pm * 256u * 1024u;
        const unsigned uB = gu ? wgu + ((unsigned)e * 512u + (unsigned)(pn & 1) * 256u) * 2048u : wdn + ((unsigned)elo * 1024u + (unsigned)pn * 256u) * 512u;
        const unsigned uB2 = gu ? 0u : wdn + ((unsigned)ehi * 1024u + (unsigned)pn * 256u) * 512u;
        const int* ur = gu ? (const int*)(ws + WS_ROWG) + r0 : (const int*)nullptr;
        u.A = uA; u.B = uB; u.lda = gu ? 2048u : 1024u; u.ldb = gu ? 2048u : 512u; u.nt = gu ? 16 : 8; u.fin = 1; u.rows = ur; u.nv = nv;
        u.pm = pm; u.pn = pn; u.a0 = gu ? pn : 1; u.r0 = r0; u.kind = kind; u.dep = gu ? -1 : CW_DEP + l * 256 + pm; u.B2 = uB2; return true;
    }
};
struct EpiGU {
    unsigned char* ws; int l; int samex; int pbx = 0;
    __device__ __forceinline__ void operator()(f32x4 (&acc)[2][2][4][2], const g8::Unit& u, int wr, int wc, int fr, int fq, LAS unsigned char* es) const {
        const f32x4* roww = (const f32x4*)(ws + WS_ROWW) + u.r0;
        const __amdgpu_buffer_rsrc_t rs = __builtin_amdgcn_make_buffer_rsrc((void*)ws, 0, 0x7fffffff, 0x00020000);
        f32x4 rw[2][4];
#pragma unroll
        for (int ai = 0; ai < 2; ++ai)
#pragma unroll
            for (int m = 0; m < 4; ++m) { const int R = ai * 128 + wr * 64 + m * 16 + fr; rw[ai][m] = R < u.nv ? roww[R] : (f32x4){0.f, 0.f, 0.f, 0.f}; }
#pragma unroll
        for (int ai = 0; ai < 2; ++ai)
#pragma unroll
            for (int m = 0; m < 4; ++m) { const int R = ai * 128 + wr * 64 + m * 16 + fr; const size_t pos = (size_t)u.pm * 256 + R;
                const float r2 = rw[ai][m].z, w = (u.a0 >> 1) ? rw[ai][m].y : rw[ai][m].x; float o[8];
                const float c2 = -r2 * LOG2E, kk = r2 * r2 * w;
#pragma unroll
                for (int n = 0; n < 2; ++n)
#pragma unroll
                    for (int j = 0; j < 4; ++j) { const float g_ = acc[ai][0][m][n][j], u_ = acc[ai][1][m][n][j];
                        o[n * 4 + j] = (g_ * u_) * kk * __builtin_amdgcn_rcpf(1.f + __builtin_amdgcn_exp2f(g_ * c2)); }
                u32x4 wv; wv.x = pk2(o[0], o[1]); wv.y = pk2(o[2], o[3]); wv.z = pk2(o[4], o[5]); wv.w = pk2(o[6], o[7]);
                const unsigned so = (unsigned)(WS_ACT + (pos * 512 + u.a0 * 128 + wc * 32 + 8 * fq) * 2);
                if (samex || (pbx & 1)) __builtin_amdgcn_raw_buffer_store_b128(wv, rs, so, 0, 0);
                else __builtin_amdgcn_raw_buffer_store_b128(wv, rs, so, 0, 16); }
        if (!(pbx & 2)) asm volatile("s_waitcnt vmcnt(0)" ::: "memory");
        if (fr == 0 && fq == 0) __hip_atomic_fetch_add((unsigned*)ws + CW_DEP + l * 256 + u.pm, 1u, __ATOMIC_RELAXED, __HIP_MEMORY_SCOPE_AGENT);
    }
};
struct EpiDown {
    unsigned char* ws; float* xout;
    __device__ __forceinline__ void operator()(f32x4 (&acc)[2][2][4][2], const g8::Unit& u, int wr, int wc, int fr, int fq, LAS unsigned char* es) const {
        if (u.a0 == 0) return;
        const int* rowg = (const int*)(ws + WS_ROWG) + u.r0; bf16* xb = (bf16*)(ws + WS_XB); float* ssx = (float*)(ws + WS_SSQX);
        int tk[2][4];
#pragma unroll
        for (int ai = 0; ai < 2; ++ai)
#pragma unroll
            for (int m = 0; m < 4; ++m) { const int R = ai * 128 + wr * 64 + m * 16 + fr; tk[ai][m] = R < u.nv ? rowg[R] : -1; }
#pragma unroll
        for (int ai = 0; ai < 2; ++ai) {
            u32x4 xo[4][2];
#pragma unroll
            for (int m = 0; m < 4; ++m)
#pragma unroll
                for (int bj = 0; bj < 2; ++bj) xo[m][bj] = *(const u32x4*)(xb + (size_t)(tk[ai][m] < 0 ? 0 : tk[ai][m]) * DM + u.pn * 256 + bj * 128 + wc * 32 + 8 * fq);
#pragma unroll
            for (int m = 0; m < 4; ++m) { const int tok = tk[ai][m]; float ss = 0.f;
                if (tok >= 0) {
#pragma unroll
                    for (int bj = 0; bj < 2; ++bj) { const size_t off = (size_t)tok * DM + u.pn * 256 + bj * 128 + wc * 32 + 8 * fq; const u32x4 x = xo[m][bj];
                        const f32x4 x0 = (f32x4){bf2f(x.x & 0xffffu), bf2f(x.x >> 16), bf2f(x.y & 0xffffu), bf2f(x.y >> 16)}, x1 = (f32x4){bf2f(x.z & 0xffffu), bf2f(x.z >> 16), bf2f(x.w & 0xffffu), bf2f(x.w >> 16)};
                        const f32x4 v0 = x0 + acc[ai][bj][m][0], v1 = x1 + acc[ai][bj][m][1];
                        if (xout) { *(f32x4*)(xout + off) = v0; *(f32x4*)(xout + off + 4) = v1; }
                        else { u32x4 w; w.x = pk2(v0.x, v0.y); w.y = pk2(v0.z, v0.w); w.z = pk2(v1.x, v1.y); w.w = pk2(v1.z, v1.w);
                            *(u32x4*)(xb + off) = w;
#pragma unroll
                            for (int e = 0; e < 4; ++e) { const float a = bf2f(w[e] & 0xffffu), c = bf2f(w[e] >> 16); ss += a * a + c * c; } } } }
                ss = sum_xor32(sum_xor16(ss));
                if (tok >= 0 && fq == 0) ssx[(size_t)tok * 16 + u.pn * 4 + wc] = ss; } }
    }
};
struct EpiMoe {
    EpiGU gu; EpiDown dn;
    __device__ __forceinline__ void operator()(f32x4 (&acc)[2][2][4][2], const g8::Unit& u, int wr, int wc, int fr, int fq, LAS unsigned char* es) const {
        if (u.kind == 0) gu(acc, u, wr, wc, fr, fq, es); else dn(acc, u, wr, wc, fr, fq, es);
    }
};
__device__ __forceinline__ void phase_moe(Frame& F, int l, int pbx = 0) {
    unsigned char* ws = F.ws;
    moe_table(F, l);
    SchedMoe S{ws, (unsigned)(WS_W + (size_t)l * WL_SIZE + WL_WGU), (unsigned)(WS_W + (size_t)l * WL_SIZE + WL_WDN), (const LAS int*)(F.lds + LDS_BTAB), l, F.G, (int)blockIdx.x};
    int samex;
    {   const unsigned mine = (unsigned)__builtin_amdgcn_s_getreg((3 << 11) | 20) & 0xFu;
        const unsigned v = ((const unsigned*)ws)[CW_XCC + (F.lane & 31) * 8 + ((int)blockIdx.x & 7)];
        samex = (F.G == 256 && __builtin_amdgcn_ballot_w64(v != mine) == 0ull) ? 1 : 0; }
    if (pbx) samex = 0;
    EpiMoe E{EpiGU{ws, l, samex, pbx}, EpiDown{ws, l == DEPTH - 1 ? F.out : nullptr}};
    g8::gemm_phase(F.lds, F.tid, F.ws, S, E);
}

#if defined(PROBE_SET)
struct EpiMoeNone { unsigned char* ws; int l;
    __device__ __forceinline__ void operator()(f32x4 (&acc)[2][2][4][2], const g8::Unit& u, int wr, int wc, int fr, int fq, LAS unsigned char* es) const {
#pragma unroll
        for (int a = 0; a < 2; ++a)
#pragma unroll
            for (int b = 0; b < 2; ++b)
#pragma unroll
                for (int m = 0; m < 4; ++m) asm volatile("" :: "v"(acc[a][b][m][0]), "v"(acc[a][b][m][1])); } };
__device__ __forceinline__ void phase_moe_noepi(Frame& F, int l) {
    unsigned char* ws = F.ws;
    moe_table(F, l);
    SchedMoe S{ws, (unsigned)(WS_W + (size_t)l * WL_SIZE + WL_WGU), (unsigned)(WS_W + (size_t)l * WL_SIZE + WL_WDN), (const LAS int*)(F.lds + LDS_BTAB), l, F.G, (int)blockIdx.x};
    EpiMoeNone E{ws, l};
    g8::gemm_phase(F.lds, F.tid, F.ws, S, E);
}
#endif


constexpr int PH_PREP = 0, PH_PER_LAYER = 10;
constexpr int PL_INPROJ = 0, PL_ATTN = 1, PL_SCAN = 2, PL_S5B = 3, PL_GLU = 4, PL_OUTPROJ = 5, PL_ROUTER = 6, PL_SCATTER = 7, PL_GU = 8, PL_DOWN = 9;
constexpr int N_PHASES = 1 + DEPTH * PH_PER_LAYER;


#define XB_TMO      128
#define XB_XCNT(j)  (256  + 64 * (j))
#define XB_XSUB(j)  (1280 + 64 * (j))
#define XB_XGEN(j)  (2304 + 64 * (j))
#define XB_TOP      3328
#define XB_TOPGEN   3392
#define XB_LSUB(j)  (3456 + 64 * (j))
#define XB_LGEN(j)  (4480 + 64 * (j))
#define XCD_BAR_WORDS 3456
#define XB_SPIN_CAP (1u << 20)
__device__ __forceinline__ unsigned xb_ld(unsigned* p)              { return __hip_atomic_load(p, __ATOMIC_RELAXED, __HIP_MEMORY_SCOPE_AGENT); }
__device__ __forceinline__ unsigned xb_add(unsigned* p, unsigned v) { return __hip_atomic_fetch_add(p, v, __ATOMIC_RELAXED, __HIP_MEMORY_SCOPE_AGENT); }
__device__ __forceinline__ unsigned xb_xcc_id() { return (unsigned)__builtin_amdgcn_s_getreg((3 << 11) | 20) & 0xFu; }
#define XB_SPIN(cond, bar) do { unsigned _sp = 0; while (cond) { __builtin_amdgcn_s_sleep(1); \
    if ((++_sp & 255u) == 0u) { if (xb_ld(&(bar)[XB_TMO])) break; if (_sp > XB_SPIN_CAP) { atomicAdd(&(bar)[XB_TMO], 1u); break; } } } } while (0)
struct XcdBarrier { unsigned* bar; unsigned x; volatile LAS unsigned* st; };
__device__ __forceinline__ XcdBarrier xcd_barrier_post(unsigned* bar, volatile LAS unsigned* st, bool leader) {
    XcdBarrier b; b.bar = bar; b.x = xb_xcc_id(); b.st = st;
    if (leader) (void)xb_add(&bar[XB_XCNT(b.x)], 1u);
    return b;
}
__device__ __forceinline__ void xcd_barrier_complete(unsigned* bar, unsigned x, unsigned& nloc, unsigned& nx) {
    const unsigned G = gridDim.x * gridDim.y * gridDim.z;
    unsigned sum, cnt, mine, sp = 0u;
    for (;;) {
        sum = 0u; cnt = 0u; mine = 0u;
#pragma unroll
        for (unsigned j = 0; j < 16; ++j) { const unsigned c = xb_ld(&bar[XB_XCNT(j)]); sum += c; cnt += (c > 0u) ? 1u : 0u; mine = (j == x) ? c : mine; }
        if (sum == G) break;
        __builtin_amdgcn_s_sleep(1);
        if ((++sp & 255u) == 0u) { if (xb_ld(&bar[XB_TMO])) break; if (sp > XB_SPIN_CAP) { atomicAdd(&bar[XB_TMO], 1u); break; } }
    }
    nloc = mine > 0u ? mine : 1u; nx = cnt > 0u ? cnt : 1u;
}
__device__ __forceinline__ void xcd_barrier(const XcdBarrier& b, bool leader) {
    asm volatile("s_waitcnt vmcnt(0)" ::: "memory");
    __syncthreads();
    if (leader) {
        unsigned* bar = b.bar;
        __builtin_amdgcn_s_waitcnt(0);
        unsigned nloc = b.st[0], nx = b.st[1];
        if (nloc == 0u) { xcd_barrier_complete(bar, b.x, nloc, nx); b.st[0] = nloc; b.st[1] = nx; }
        const unsigned old = xb_add(&bar[XB_XSUB(b.x)], 1u);
        const unsigned gen = old / nloc;
        if (old + 1u == (gen + 1u) * nloc) {
            __builtin_amdgcn_fence(__ATOMIC_RELEASE, "agent");
            asm volatile("s_waitcnt vmcnt(0)" ::: "memory");
            const unsigned og = xb_add(&bar[XB_TOP], 1u);
            const unsigned tg = og / nx;
            if (og + 1u == (tg + 1u) * nx) xb_add(&bar[XB_TOPGEN], 1u);
            else XB_SPIN(xb_ld(&bar[XB_TOPGEN]) == tg, bar);
            __builtin_amdgcn_fence(__ATOMIC_ACQUIRE, "agent");
            asm volatile("s_waitcnt vmcnt(0)" ::: "memory");
        } else {
            XB_SPIN(xb_ld(&bar[XB_TOPGEN]) == gen, bar);
            __builtin_amdgcn_fence(__ATOMIC_ACQUIRE, "agent");
            asm volatile("s_waitcnt vmcnt(0)" ::: "memory");
        }
    }
    __syncthreads();
}
__device__ __forceinline__ void xcd_barrier_local(const XcdBarrier& b, bool leader) {
    asm volatile("s_waitcnt vmcnt(0)" ::: "memory");
    __syncthreads();
    if (leader) {
        unsigned* bar = b.bar;
        __builtin_amdgcn_s_waitcnt(0);
        const unsigned nloc = b.st[0];
        const unsigned old = xb_add(&bar[XB_LSUB(b.x)], 1u);
        const unsigned gen = old / nloc;
        if (old + 1u == (gen + 1u) * nloc) xb_add(&bar[XB_LGEN(b.x)], 1u);
        else XB_SPIN(xb_ld(&bar[XB_LGEN(b.x)]) == gen, bar);
        __builtin_amdgcn_fence(__ATOMIC_ACQUIRE, "agent");
        asm volatile("s_waitcnt vmcnt(0)" ::: "memory");
    }
    __syncthreads();
}
constexpr int LDS_BARST = LDS_MISC - 16;
constexpr size_t CTL_ZERO_BYTES = 64 * 1024;

struct Args { P p; int ph_lo, ph_hi; };

__global__ void __launch_bounds__(NTHR, 2) mk(Args args) {
    extern __shared__ __attribute__((aligned(16))) unsigned char lds_raw[];
    Frame F;
    F.lds = (LAS unsigned char*)lds_raw; F.ldsg = (char*)lds_raw;
    F.tid = threadIdx.x; F.lane = F.tid & 63; F.wave = __builtin_amdgcn_readfirstlane(F.tid >> 6);
    F.G = gridDim.x; { const int bx = blockIdx.x; F.vcu = (F.G % 8 == 0) ? (bx % 8) * (F.G / 8) + bx / 8 : bx; }
    {   LAS unsigned* pw = (LAS unsigned*)(F.lds + LDS_MISC);
        if (threadIdx.x < sizeof(P) / 4) pw[threadIdx.x] = ((const unsigned*)&args.p)[threadIdx.x];
        F.pl = (const LAS P*)pw; }
    if (threadIdx.x < 4) ((LAS unsigned*)(F.lds + LDS_BARST))[threadIdx.x] = 0u;
    __syncthreads();
    const int lo = args.ph_lo, hi = args.ph_hi;
    if (hi - lo > 1) (void)xcd_barrier_post((unsigned*)uniptr(F.pl->ws) + 1024, (volatile LAS unsigned*)(F.lds + LDS_BARST), threadIdx.x == 0);
#define GRID_BAR() do { XcdBarrier bar_; bar_.bar = (unsigned*)uniptr(F.pl->ws) + 1024; bar_.x = xb_xcc_id(); bar_.st = (volatile LAS unsigned*)(F.lds + LDS_BARST); \
        int ln2_; asm volatile("v_mbcnt_lo_u32_b32 %0, -1, 0\n\tv_mbcnt_hi_u32_b32 %0, -1, %0" : "=v"(ln2_)); xcd_barrier(bar_, F.wave == 0 && ln2_ == 0); } while (0)
#define XCC_CHECK() do { int ln3_; asm volatile("v_mbcnt_lo_u32_b32 %0, -1, 0\n\tv_mbcnt_hi_u32_b32 %0, -1, %0" : "=v"(ln3_)); const unsigned* tb_ = (const unsigned*)uniptr(F.pl->ws) + 7168; bool bad_ = false; \
        _Pragma("unroll") for (int i_ = 0; i_ < 4; ++i_) { const int c_ = ln3_ + 64 * i_; bad_ = bad_ || (tb_[c_] != tb_[c_ & 7]); } \
        const bool all_ = F.G == 256 && __builtin_amdgcn_ballot_w64(bad_) == 0ull; \
        if (F.wave == 0 && ln3_ == 0) ((volatile LAS unsigned*)(F.lds + LDS_BARST))[2] = all_ ? 2u : 1u; __syncthreads(); } while (0)
#define GRID_BAR_LOCAL() do { XcdBarrier bar_; bar_.bar = (unsigned*)uniptr(F.pl->ws) + 1024; bar_.x = xb_xcc_id(); bar_.st = (volatile LAS unsigned*)(F.lds + LDS_BARST); \
        int ln2_; asm volatile("v_mbcnt_lo_u32_b32 %0, -1, 0\n\tv_mbcnt_hi_u32_b32 %0, -1, %0" : "=v"(ln2_)); \
        if (__builtin_amdgcn_readfirstlane(bar_.st[2]) == 2u) xcd_barrier_local(bar_, F.wave == 0 && ln2_ == 0); else xcd_barrier(bar_, F.wave == 0 && ln2_ == 0); } while (0)
#define PHASE_ENTER() do { int ln_; asm volatile("v_mbcnt_lo_u32_b32 %0, -1, 0\n\tv_mbcnt_hi_u32_b32 %0, -1, %0" : "=v"(ln_) :: "memory"); F.lane = ln_; F.tid = F.wave * 64 + ln_; \
        F.ws = (unsigned char*)uniptr(F.pl->ws); F.out = (float*)uniptr(F.pl->out); } while (0)
#define RUN(ph, call) do { if (lo <= (ph) && (ph) < hi) { PHASE_ENTER(); call; if ((ph) + 1 < hi) GRID_BAR(); } } while (0)
#define RUNL(ph, call) do { if (lo <= (ph) && (ph) < hi) { PHASE_ENTER(); call; if ((ph) + 1 < hi) GRID_BAR_LOCAL(); } } while (0)
    RUN(PH_PREP, { phase_prep<1>(F); phase_prep<0>(F); });
#if defined(PROBE_SET)
    if ((PROBE_SET) & (1 << 13)) { PHASE_ENTER(); phase_prep<0>(F); GRID_BAR(); }
    if ((PROBE_SET) & (1 << 14)) { PHASE_ENTER(); phase_inproj(F, 0); GRID_BAR(); }
    if ((PROBE_SET) & (1 << 15)) { PHASE_ENTER(); phase_inproj(F, 0); GRID_BAR(); PHASE_ENTER(); phase_s5a(F, 0); phase_attn_a(F, 0); phase_attn_b(F, 0); GRID_BAR(); }
#endif
#define LAYER(l) do { \
        RUNL(1 + (l) * PH_PER_LAYER + PL_INPROJ, phase_inproj(F, (l))); \
        RUN(1 + (l) * PH_PER_LAYER + PL_ATTN, { phase_s5a(F, (l)); if (F.G == 256) phase_attn_ab(F, (l)); else { phase_attn_a(F, (l)); phase_attn_b(F, (l)); } phase_s5b(F, (l)); }); \
        RUNL(1 + (l) * PH_PER_LAYER + PL_GLU, phase_glu(F, (l))); \
        RUNL(1 + (l) * PH_PER_LAYER + PL_OUTPROJ, phase_outproj(F, (l))); \
        RUN(1 + (l) * PH_PER_LAYER + PL_ROUTER, phase_router(F, (l))); \
        RUN(1 + (l) * PH_PER_LAYER + PL_GU, phase_moe(F, (l))); \
    } while (0)
    if (lo == 0 && hi == N_PHASES) XCC_CHECK();
    LAYER(0);
    LAYER(1);
#if defined(PROBE_SET)
    if (hi == N_PHASES) {
        GRID_BAR();
#define PRB(bit, call) do { if ((PROBE_SET) & (1 << (bit))) { PHASE_ENTER(); call; GRID_BAR(); } } while (0)
        if ((PROBE_SET) & (1 << 19)) { for (int r_ = 0; r_ < 10; ++r_) GRID_BAR(); }
        PRB(0, phase_prep<1>(F));
        PRB(1, phase_inproj(F, 1));
        PRB(16, phase_inproj_noepi(F, 1));
        PRB(17, phase_inproj_nostore(F, 1));
        PRB(2, phase_attn_a(F, 1));
        PRB(3, phase_attn_b(F, 1));
        PRB(4, phase_s5a(F, 1));
        PRB(6, phase_s5b(F, 1));
        PRB(7, phase_glu(F, 1));
        PRB(8, phase_outproj(F, 1));
        PRB(9, phase_router(F, 1));
        PRB(11, phase_moe(F, 0));
        PRB(20, phase_moe_noepi(F, 0));
        PRB(22, phase_moe(F, 0, 3));
        PRB(23, phase_moe(F, 0, 1));
        PRB(24, phase_moe(F, 0, 2));
        PRB(25, phase_moe(F, 0, 4));
    }
#endif
}

extern "C" void kernel_launch(void* const* d_in, const int* in_sizes, int n_in, void* d_out, int out_size, void* d_ws, size_t ws_size, hipStream_t stream) {
    if (n_in != 28 || out_size != T * DM || ws_size < WS_END2) { fprintf(stderr, "kernel_launch: unexpected shapes (n_in %d out %d ws %zu)\n", n_in, out_size, ws_size); return; }
    static int grid = 0;
    if (grid == 0) {
        int dev = 0, cus = 0;
        if (hipGetDevice(&dev) != hipSuccess || hipDeviceGetAttribute(&cus, hipDeviceAttributeMultiprocessorCount, dev) != hipSuccess) { fprintf(stderr, "kernel_launch: device query failed\n"); grid = -1; return; }
        if (hipFuncSetAttribute((const void*)mk, hipFuncAttributeMaxDynamicSharedMemorySize, LDS_BYTES) != hipSuccess) { fprintf(stderr, "kernel_launch: hipFuncSetAttribute failed\n"); grid = -1; return; }
        if (cus < 256) { fprintf(stderr, "kernel_launch: %d CUs; this kernel is built for a 256-CU device\n", cus); grid = -1; return; }
        grid = 256;
    }
    if (grid < 0) return;
    Args a{};
    for (int i = 0; i < 28; ++i) a.p.in[i] = (const float*)d_in[i];
    a.p.out = (float*)d_out; a.p.ws = (unsigned char*)d_ws;
    const P& p = a.p;
    if (hipMemsetAsync((char*)d_ws + WS_CTL, 0, CTL_ZERO_BYTES, stream) != hipSuccess) { fprintf(stderr, "kernel_launch: hipMemsetAsync failed\n"); return; }
    a.ph_lo = 0; a.ph_hi = N_PHASES;
    void* kargs[] = {&a};
    hipError_t e = hipLaunchCooperativeKernel((const void*)mk, dim3(grid), dim3(NTHR), kargs, LDS_BYTES, stream);
    if (e != hipSuccess) fprintf(stderr, "kernel_launch: cooperative launch failed: %s (grid %d)\n", hipGetErrorString(e), grid);
}
```
